# Optimizing an MI355X kernel written in HIP

```python
import jax, jax.numpy as jnp
from jax import lax
import numpy as np

D_MODEL = 1024
BATCH = 16
SEQ = 4096
DEPTH = 1

CTX_LEN = 256
GRID_W = 64
F32 = jnp.float32
EPS = 1e-6
N_MOD = 6
D_MIX = D_MODEL
D_LRU = D_MIX // 2
LRU_BLOCKS = 8
LRU_BLOCK_DIM = D_LRU // LRU_BLOCKS
CONV_W = 4
LRU_C = 8.0
D_RET = D_MIX - D_LRU
RET_HEADS = 4
RET_HEAD_DIM = D_RET // RET_HEADS
RET_CHUNK = 128
ROPE_BASE = 10000.0
N_EXPERTS = 64
TOP_K = 6
N_GROUPS = 8
TOP_GROUPS = 4
D_EXPERT = D_MODEL // 4
D_SHARED = D_EXPERT
ROUTE_SCALE = 2.5
MOE_BLOCK = 128

kernel_name = "hybrid_lru_retention_moe_dit_block"


def rmsnorm(x, g):
    x32 = x.astype(F32)
    y = x32 * lax.rsqrt(jnp.mean(x32 * x32, axis=-1, keepdims=True) + EPS)
    return (y * g.astype(F32)).astype(x.dtype)


def modulate(h, shift, scale):
    return h * (1.0 + scale) + shift


def swiglu(x, w_gate, w_up, w_down):
    return (jax.nn.silu(x @ w_gate) * (x @ w_up)) @ w_down


def dwconv(u, w, b):
    T = u.shape[1]
    left = CONV_W // 2
    up = jnp.pad(u, ((0, 0), (left, CONV_W - 1 - left), (0, 0)))
    return b + sum(w[j] * up[:, j:j + T] for j in range(CONV_W))


def _lin_combine(e1, e2):
    a1, b1 = e1
    a2, b2 = e2
    return a1 * a2, a2 * b1 + b2


def linear_scan(a, b, h0, reverse):
    if reverse:
        a, b = a[:, ::-1], b[:, ::-1]
    b = b.at[:, 0].add(a[:, 0] * h0)
    _, h = lax.associative_scan(_lin_combine, (a, b), axis=1)
    return h[:, ::-1] if reverse else h


def lru_gates(u, w_rec, b_rec, w_inp, b_inp, lam):
    B, T, _ = u.shape
    ub = u.reshape(B, T, LRU_BLOCKS, LRU_BLOCK_DIM)
    r = jax.nn.sigmoid(jnp.einsum('bthi,hij->bthj', ub, w_rec).reshape(B, T, D_LRU) + b_rec)
    i = jax.nn.sigmoid(jnp.einsum('bthi,hij->bthj', ub, w_inp).reshape(B, T, D_LRU) + b_inp)
    log_a = -LRU_C * r * jax.nn.softplus(-lam)
    return jnp.exp(log_a), jnp.sqrt(-jnp.expm1(2.0 * log_a)) * (i * u)


def lru_direction(u_lat, u_ctx, w_rec, b_rec, w_inp, b_inp, lam, reverse):
    w_rec, b_rec, w_inp, b_inp, lam = (p.astype(F32) for p in (w_rec, b_rec, w_inp, b_inp, lam))
    a_c, b_c = lru_gates(u_ctx, w_rec, b_rec, w_inp, b_inp, lam)
    h_ctx = linear_scan(a_c, b_c, jnp.zeros_like(b_c[:, 0]), reverse)
    h_end = h_ctx[:, 0] if reverse else h_ctx[:, -1]
    a_x, b_x = lru_gates(u_lat, w_rec, b_rec, w_inp, b_inp, lam)
    return linear_scan(a_x, b_x, h_end, reverse), h_ctx


def rope_1d(x, pos):
    half = x.shape[-1] // 2
    freqs = ROPE_BASE ** (-jnp.arange(half, dtype=F32) / half)
    ang = pos[:, None] * freqs[None, :]
    cos = jnp.cos(ang)[None, :, None, :]
    sin = jnp.sin(ang)[None, :, None, :]
    x1, x2 = x[..., :half], x[..., half:]
    return jnp.concatenate([x1 * cos - x2 * sin, x1 * sin + x2 * cos], axis=-1)


def rope_2d(x, row, col):
    h = x.shape[-1] // 2
    return jnp.concatenate([rope_1d(x[..., :h], row), rope_1d(x[..., h:], col)], axis=-1)


def head_rms(o):
    return o * lax.rsqrt(jnp.mean(o * o, axis=-1, keepdims=True) + EPS)


def retention_chunkwise(q, k, v, log_g, s0, inclusive):
    B, T, H, dk = q.shape
    dv = v.shape[-1]
    C = RET_CHUNK
    n = T // C
    qc = q.reshape(B, n, C, H, dk)
    kc = k.reshape(B, n, C, H, dk)
    vc = v.reshape(B, n, C, H, dv)
    idx = jnp.arange(C, dtype=F32)
    diff = idx[:, None] - idx[None, :]
    mask = (diff >= 0) if inclusive else (diff > 0)
    dmat = jnp.where(mask[None], jnp.exp(jnp.where(mask, diff, 0.0)[None] * log_g[:, None, None]), 0.0)
    scores = jnp.einsum('bnihd,bnjhd->bnhij', qc, kc) * dmat
    intra = jnp.einsum('bnhij,bnjhe->bnihe', scores, vc)
    zeta = jnp.exp((C - 1 - idx)[:, None] * log_g[None, :])
    xi = jnp.exp((idx + 1.0)[:, None] * log_g[None, :])
    chunk_kv = jnp.einsum('bnjhd,jh,bnjhe->nbhde', kc, zeta, vc)
    decay_chunk = jnp.exp(C * log_g)[None, :, None, None]

    def step(state, kv):
        return decay_chunk * state + kv, state

    _, s_prev = lax.scan(step, s0, chunk_kv)
    cross = jnp.einsum('bnihd,ih,nbhde->bnihe', qc, xi, s_prev)
    return (intra + cross).reshape(B, T, H, dv)


def context_states(k, v, log_g):
    L = k.shape[1]
    pos = jnp.arange(L, dtype=F32)
    wf = jnp.exp((L - 1 - pos)[:, None] * log_g[None, :])
    wb = jnp.exp(pos[:, None] * log_g[None, :])
    s_f = jnp.einsum('bmhd,mh,bmhe->bhde', k, wf, v)
    s_b = jnp.einsum('bmhd,mh,bmhe->bhde', k, wb, v)
    return s_f, s_b


def retention_context(q, k, v, log_g):
    L = q.shape[1]
    pos = jnp.arange(L, dtype=F32)
    dist = jnp.abs(pos[:, None] - pos[None, :])
    dmat = jnp.exp(dist[None] * log_g[:, None, None])
    scores = jnp.einsum('bnhd,bmhd->bhnm', q, k) * dmat
    return jnp.einsum('bhnm,bmhe->bnhe', scores, v)


def mixer(hx, hc, w_in, conv_w, conv_b, w_rec, b_rec, w_inp, b_inp, lam, w_out, row, col, log_g, need_ctx_out):
    B, T, _ = hx.shape
    L = hc.shape[1]
    xa, ga, q, k, v, g = jnp.split((hx @ w_in).astype(F32), 6, axis=-1)
    xa_c, ga_c, q_c, k_c, v_c, g_c = jnp.split((hc @ w_in).astype(F32), 6, axis=-1)
    cw, cb = conv_w.astype(F32), conv_b.astype(F32)
    u, u_c = dwconv(xa, cw, cb), dwconv(xa_c, cw, cb)
    h_f, hc_f = lru_direction(u, u_c, w_rec[0], b_rec[0], w_inp[0], b_inp[0], lam[0], False)
    h_b, hc_b = lru_direction(u, u_c, w_rec[1], b_rec[1], w_inp[1], b_inp[1], lam[1], True)
    y_lru = (h_f + h_b) * jax.nn.gelu(ga)
    scale = RET_HEAD_DIM ** -0.5
    qh = rope_2d(q.reshape(B, T, RET_HEADS, RET_HEAD_DIM), row, col)
    kh = rope_2d(k.reshape(B, T, RET_HEADS, RET_HEAD_DIM), row, col) * scale
    vh = v.reshape(B, T, RET_HEADS, RET_HEAD_DIM)
    kh_c = k_c.reshape(B, L, RET_HEADS, RET_HEAD_DIM) * scale
    vh_c = v_c.reshape(B, L, RET_HEADS, RET_HEAD_DIM)
    s_f, s_b = context_states(kh_c, vh_c, log_g)
    o = retention_chunkwise(qh, kh, vh, log_g, s_f, True) + \
        retention_chunkwise(qh[:, ::-1], kh[:, ::-1], vh[:, ::-1], log_g, s_b, False)[:, ::-1]
    y_ret = head_rms(o).reshape(B, T, D_RET) * jax.nn.silu(g)
    out = (jnp.concatenate([y_lru, y_ret], axis=-1) @ w_out.astype(F32)).astype(hx.dtype)
    if not need_ctx_out:
        return out, None
    qh_c = q_c.reshape(B, L, RET_HEADS, RET_HEAD_DIM)
    y_lru_c = (hc_f + hc_b) * jax.nn.gelu(ga_c)
    y_ret_c = head_rms(retention_context(qh_c, kh_c, vh_c, log_g)).reshape(B, L, D_RET) * jax.nn.silu(g_c)
    out_c = (jnp.concatenate([y_lru_c, y_ret_c], axis=-1) @ w_out.astype(F32)).astype(hc.dtype)
    return out, out_c


def routed_experts(x, eidx, gates, w1, w3, w2):
    N, D = x.shape
    NK = N * TOP_K
    e_flat = eidx.reshape(-1)
    tok_flat = jnp.repeat(jnp.arange(N, dtype=jnp.int32), TOP_K)
    g_flat = gates.reshape(-1)
    order = jnp.argsort(e_flat)
    e_sorted, tok_sorted, g_sorted = e_flat[order], tok_flat[order], g_flat[order]
    counts = jnp.bincount(e_flat, length=N_EXPERTS)
    starts = jnp.cumsum(counts) - counts
    padded = (counts + MOE_BLOCK - 1) // MOE_BLOCK * MOE_BLOCK
    pends = jnp.cumsum(padded)
    pstarts = pends - padded
    dest = pstarts[e_sorted] + jnp.arange(NK, dtype=jnp.int32) - starts[e_sorted]
    n_blocks = -(-NK // MOE_BLOCK) + N_EXPERTS
    P = n_blocks * MOE_BLOCK
    tok_buf = jnp.zeros((P,), jnp.int32).at[dest].set(tok_sorted)
    g_buf = jnp.zeros((P,), F32).at[dest].set(g_sorted)
    block_expert = jnp.clip(jnp.searchsorted(pends, jnp.arange(n_blocks) * MOE_BLOCK, side='right'), 0, N_EXPERTS - 1)

    def run_block(args):
        tok, gw, e = args
        return swiglu(x[tok], w1[e], w3[e], w2[e]).astype(F32) * gw[:, None]

    y = lax.map(run_block, (tok_buf.reshape(n_blocks, MOE_BLOCK), g_buf.reshape(n_blocks, MOE_BLOCK), block_expert))
    return jax.ops.segment_sum(y.reshape(P, D), tok_buf, num_segments=N)


def moe(h, w_router, b_router, w1, w3, w2, ws1, ws3, ws2):
    B, T, D = h.shape
    x = h.reshape(B * T, D)
    N = x.shape[0]
    s = jax.nn.sigmoid(x.astype(F32) @ w_router.astype(F32))
    sb = s + b_router.astype(F32)
    grp = sb.reshape(N, N_GROUPS, N_EXPERTS // N_GROUPS)
    gscore = lax.top_k(grp, 2)[0].sum(-1)
    _, gidx = lax.top_k(gscore, TOP_GROUPS)
    gmask = jnp.repeat(jax.nn.one_hot(gidx, N_GROUPS, dtype=F32).sum(1), N_EXPERTS // N_GROUPS, axis=1)
    _, eidx = lax.top_k(jnp.where(gmask > 0, sb, -jnp.inf), TOP_K)
    sel = jnp.take_along_axis(s, eidx, axis=1)
    gates = sel / jnp.sum(sel, axis=-1, keepdims=True) * ROUTE_SCALE
    routed = routed_experts(x, eidx, gates, w1, w3, w2)
    shared = swiglu(x, ws1, ws3, ws2).astype(F32)
    return (routed + shared).astype(h.dtype).reshape(B, T, D)


def setup_inputs(seed: int = 0) -> dict:
    key = jax.random.key(seed)
    ks = jax.random.split(key, 28)

    def nrm(k, shape, scale):
        return jax.random.normal(k, shape, F32) * scale

    u = jax.random.uniform(ks[15], (DEPTH, 2, D_LRU), F32, minval=0.9, maxval=0.999)
    s = u ** (1.0 / LRU_C)
    return {
        'x': nrm(ks[0], (BATCH, SEQ, D_MODEL), 1.0),
        'c': nrm(ks[1], (BATCH, D_MODEL), 1.0),
        'ctx': nrm(ks[2], (BATCH, CTX_LEN, D_MODEL), 1.0),
        'c_ctx': nrm(ks[3], (D_MODEL,), 1.0),
        'w_mod': nrm(ks[4], (DEPTH, D_MODEL, N_MOD * D_MODEL), D_MODEL ** -0.5),
        'b_mod': nrm(ks[5], (DEPTH, N_MOD * D_MODEL), 0.01),
        'norm_mix': 1.0 + nrm(ks[6], (DEPTH, D_MODEL), 0.01),
        'norm_ffn': 1.0 + nrm(ks[7], (DEPTH, D_MODEL), 0.01),
        'w_in': nrm(ks[8], (DEPTH, D_MODEL, 2 * D_LRU + 4 * D_RET), D_MODEL ** -0.5),
        'conv_w': nrm(ks[9], (DEPTH, CONV_W, D_LRU), CONV_W ** -0.5),
        'conv_b': nrm(ks[10], (DEPTH, D_LRU), 0.01),
        'lru_w_rec': nrm(ks[11], (DEPTH, 2, LRU_BLOCKS, LRU_BLOCK_DIM, LRU_BLOCK_DIM), LRU_BLOCK_DIM ** -0.5),
        'lru_b_rec': nrm(ks[12], (DEPTH, 2, D_LRU), 0.01),
        'lru_w_in': nrm(ks[13], (DEPTH, 2, LRU_BLOCKS, LRU_BLOCK_DIM, LRU_BLOCK_DIM), LRU_BLOCK_DIM ** -0.5),
        'lru_b_in': nrm(ks[14], (DEPTH, 2, D_LRU), 0.01),
        'lru_lambda': jnp.log(s) - jnp.log1p(-s),
        'w_out': nrm(ks[16], (DEPTH, D_MIX, D_MODEL), D_MIX ** -0.5),
        'w_router': nrm(ks[17], (DEPTH, D_MODEL, N_EXPERTS), D_MODEL ** -0.5),
        'b_router': nrm(ks[18], (DEPTH, N_EXPERTS), 0.01),
        'w_exp_gate': nrm(ks[19], (DEPTH, N_EXPERTS, D_MODEL, D_EXPERT), D_MODEL ** -0.5),
        'w_exp_up': nrm(ks[20], (DEPTH, N_EXPERTS, D_MODEL, D_EXPERT), D_MODEL ** -0.5),
        'w_exp_down': nrm(ks[21], (DEPTH, N_EXPERTS, D_EXPERT, D_MODEL), D_EXPERT ** -0.5),
        'w_sh_gate': nrm(ks[22], (DEPTH, D_MODEL, D_SHARED), D_MODEL ** -0.5),
        'w_sh_up': nrm(ks[23], (DEPTH, D_MODEL, D_SHARED), D_MODEL ** -0.5),
        'w_sh_down': nrm(ks[24], (DEPTH, D_SHARED, D_MODEL), D_SHARED ** -0.5),
        'norm_final': 1.0 + nrm(ks[25], (D_MODEL,), 0.01),
    }


def reference(x, c, ctx, c_ctx, w_mod, b_mod, norm_mix, norm_ffn, w_in, conv_w, conv_b, lru_w_rec, lru_b_rec, lru_w_in, lru_b_in, lru_lambda, w_out, w_router, b_router, w_exp_gate, w_exp_up, w_exp_down, w_sh_gate, w_sh_up, w_sh_down, norm_final):
    T = x.shape[1]
    rows = T // GRID_W
    row = jnp.repeat(jnp.arange(rows, dtype=F32), GRID_W)
    col = jnp.tile(jnp.arange(GRID_W, dtype=F32), rows)
    log_g = jnp.log1p(-jnp.exp2(-(5.0 + 2.0 * jnp.arange(RET_HEADS, dtype=F32))))
    for l in range(DEPTH):
        last = l == DEPTH - 1
        mod = jax.nn.silu(c) @ w_mod[l] + b_mod[l]
        sh1, sc1, g1, sh2, sc2, g2 = jnp.split(mod[:, None, :], N_MOD, axis=-1)
        mod_c = jax.nn.silu(c_ctx) @ w_mod[l] + b_mod[l]
        csh1, csc1, cg1, csh2, csc2, cg2 = jnp.split(mod_c, N_MOD, axis=-1)
        hx = modulate(rmsnorm(x, norm_mix[l]), sh1, sc1)
        hc = modulate(rmsnorm(ctx, norm_mix[l]), csh1, csc1)
        mx, mc = mixer(hx, hc, w_in[l], conv_w[l], conv_b[l], lru_w_rec[l], lru_b_rec[l], lru_w_in[l], lru_b_in[l], lru_lambda[l], w_out[l], row, col, log_g, not last)
        x = x + g1 * mx
        ffn_args = (w_router[l], b_router[l], w_exp_gate[l], w_exp_up[l], w_exp_down[l], w_sh_gate[l], w_sh_up[l], w_sh_down[l])
        x = x + g2 * moe(modulate(rmsnorm(x, norm_ffn[l]), sh2, sc2), *ffn_args)
        if not last:
            ctx = ctx + cg1 * mc
            ctx = ctx + cg2 * moe(modulate(rmsnorm(ctx, norm_ffn[l]), csh2, csc2), *ffn_args)
    return rmsnorm(x, norm_final)
```

```cpp
#include <hip/hip_runtime.h>
#include <cstdio>
#include <cstdint>

typedef unsigned short bf16_t;
typedef float f32x4 __attribute__((ext_vector_type(4)));
typedef unsigned short u16x4 __attribute__((ext_vector_type(4)));
typedef unsigned short u16x8 __attribute__((ext_vector_type(8)));

constexpr int NB = 16, T = 4096, D = 1024, LC = 256;
constexpr int NTOK = NB * T;
constexpr int NCTX = NB * LC;
constexpr int NROWS = NCTX + NTOK;
constexpr int NPROJ = 3072;
constexpr int C_XA = 0, C_GA = 512, C_Q = 1024, C_K = 1536, C_V = 2048, C_G = 2560;
constexpr int DL = 512, NBLK = 8, BD = 64;
constexpr int NH = 4, HD = 128;
constexpr int NE = 64, TOPK = 6, DE = 256;
constexpr int NMOD = 6 * D;
__host__ __device__ __forceinline__ size_t proj_blk(int g, int blk) { return g < 2 ? ((size_t)(g * 8 + blk) * NROWS) * 64 : (size_t)2 * NROWS * 512 + ((size_t)((g - 2) * 4 + blk) * NROWS) * 128; }
constexpr float EPS = 1e-6f;

constexpr size_t MiB = 1u << 20;
constexpr size_t WS_CTL = 0, WS_MOD = 1 * MiB, WS_ROPE = 2 * MiB, WS_EIDX = 3 * MiB, WS_GATE = 5 * MiB, WS_SCTX = 7 * MiB;
constexpr size_t WS_WINT = 16 * MiB, WS_WOUTT = 23 * MiB, WS_WGUT = 25 * MiB, WS_WDT = 90 * MiB;
constexpr size_t WS_XN = 128 * MiB, WS_PROJ = 264 * MiB, WS_Y = 672 * MiB, WS_HF = 800 * MiB;
constexpr size_t WS_H2 = 368 * MiB;
constexpr size_t WS_X1B = 848 * MiB;
constexpr int NPART = 2, PTOK = NTOK / NPART, RT_ROUTED = 832, RT_PART = 960, SLOTS_PART = RT_PART * 256;
constexpr size_t WS_HIST = 512 * 1024, WS_TILE = 123 * MiB;
constexpr size_t WS_HB = 128 * MiB, WS_YT = 368 * MiB, WS_LIST = 976 * MiB, WS_END = 992 * MiB;
constexpr size_t LIST_N = (size_t)NPART * SLOTS_PART;

struct Ptrs {
    const float *x, *c, *ctx, *c_ctx, *w_mod, *b_mod, *norm_mix, *norm_ffn, *w_in, *conv_w, *conv_b, *lru_w_rec, *lru_b_rec, *lru_w_in, *lru_b_in,
        *lru_lambda, *w_out, *w_router, *b_router, *w_exp_gate, *w_exp_up, *w_exp_down, *w_sh_gate, *w_sh_up, *w_sh_down, *norm_final;
    float* out; unsigned char* ws;
};

__host__ __device__ __forceinline__ bf16_t f2bf(float f) { unsigned u = __builtin_bit_cast(unsigned, f); return (bf16_t)((u + 0x7fffu + ((u >> 16) & 1u)) >> 16); }
__host__ __device__ __forceinline__ float bf2f(bf16_t h) { return __builtin_bit_cast(float, (unsigned)h << 16); }
__device__ __forceinline__ float sigmoidf_(float v) { return 1.f / (1.f + __expf(-v)); }
__device__ __forceinline__ float siluf_(float v) { return v / (1.f + __expf(-v)); }
__device__ __forceinline__ float gelu_tanh(float v) { const float u = 0.7978845608028654f * (v + 0.044715f * v * v * v); return 0.5f * v * (1.f + tanhf(u)); }
__device__ __forceinline__ float wave_sum(float v) {
#pragma unroll
    for (int o = 1; o < 64; o <<= 1) v += __shfl_xor(v, o);
    return v;
}
__device__ __forceinline__ float ret_logg(int h) { return log1pf(-exp2f(-(5.f + 2.f * (float)h))); }
__host__ __device__ __forceinline__ int rope_src_col(int n) { const int hh = n >> 7, p = n & 127, ip = p >> 1, s = p & 1; const int d = (ip < 32) ? (ip + 32 * s) : (64 + (ip - 32) + 32 * s); return hh * 128 + d; }

#define LAS __attribute__((address_space(3)))
namespace pg8 {
typedef short bf16x8 __attribute__((ext_vector_type(8)));
typedef unsigned u32x4 __attribute__((ext_vector_type(4)));
typedef unsigned u32x2 __attribute__((ext_vector_type(2)));
constexpr int BM = 256, BK = 64, HALF = 128, HTB = HALF * BK * 2, STAGE_BYTES = 8 * HTB, NXCD = 8, WGM = 8;
__host__ __device__ __forceinline__ int lds_byte(int r, int c) { const int st = (r >> 4) * 2 + (c >> 5), rr = r & 15, cc = c & 31, ob = rr * 64 + cc * 2; return st * 1024 + (ob ^ (((ob >> 9) & 1) << 5)); }
__host__ __device__ __forceinline__ void stage_rc(int b, int& R, int& C) { const int st = b / 1024, sb = b % 1024, swz = sb ^ (((sb >> 9) & 1) << 5); R = (st >> 1) * 16 + swz / 64; C = (st & 1) * 32 + (swz % 64) / 2; }
__host__ __device__ __forceinline__ int perm32(int rho) { const int n = rho >> 4, i = rho & 15; return 8 * (i >> 2) + 4 * n + (i & 3); }
__device__ __forceinline__ unsigned cvt_pk_bf16(float lo, float hi) { unsigned r; asm volatile("v_cvt_pk_bf16_f32 %0, %1, %2" : "=v"(r) : "v"(lo), "v"(hi)); return r; }

struct Unit { const char* A; const char* B; int pm, pn, aux, pad; };

struct DenseOrder {
    const char* A; const char* B; int nM, nN, nwg, G, c, K;
    __device__ void init(const void* A_, const void* B_, int M, int N, int K_, int G_, int c_) { A = (const char*)A_; B = (const char*)B_; nM = M / BM; nN = N / BM; nwg = nM * nN; G = G_; c = c_; K = K_; }
    __device__ bool next(int i, Unit& u) const {
        const long L = (long)i * G + c; if (L >= nwg) return false;
        int wgid = (int)L; { const int q = nwg / NXCD, r = nwg % NXCD, xcd = wgid % NXCD, off = wgid / NXCD; wgid = (xcd < r ? xcd * (q + 1) : r * (q + 1) + (xcd - r) * q) + off; }
        const int nig = WGM * nN, gid = wgid / nig, fm = gid * WGM, gsz = (nM - fm) < WGM ? (nM - fm) : WGM;
        u.pm = fm + ((wgid % nig) % gsz); u.pn = (wgid % nig) / gsz; u.aux = 0; u.pad = 0;
        u.A = A + (size_t)u.pm * BM * K * 2; u.B = B + (size_t)u.pn * BM * K * 2; return true;
    }
};

template <class Epi, class Sched, bool GATHER>
__device__ __forceinline__ void gemm_phase(LAS unsigned char* lds, const int K, const Sched& S, const Epi& E, const int* rowlist) {
    const int tid = threadIdx.x, wid = __builtin_amdgcn_readfirstlane(tid >> 6), lane = tid & 63, wr = wid >> 2, wc = wid & 3, fr = lane & 15, fq = lane >> 4;
    const int nt = K / BK;
    unsigned voffA[2], voffB[2], voffB1[2]; int stR[2], stC[2];
#pragma unroll
    for (int i = 0; i < 2; ++i) { int R, C; stage_rc(tid * 16 + i * 8192, R, C); stR[i] = R; stC[i] = C;
        const int cb = 64 * (R >> 5) + 16 * ((R & 15) >> 2) + 4 * ((R >> 4) & 1) + (R & 3);
        voffA[i] = (unsigned)(R * K + C) * 2u; voffB[i] = (unsigned)(cb * K + C) * 2u; voffB1[i] = (unsigned)((cb + 8) * K + C) * 2u; }
    const size_t kstep = (size_t)(BK * 2);
    const size_t hstep = (size_t)HALF * K * 2;
    const unsigned ldsw = (unsigned)wid * 1024u;
    const int aoff = lds_byte(wr * 64 + fr, fq * 8), boff = lds_byte(wc * 32 + fr, fq * 8);
#define PG8_SA(b, h) (((b) * 2 + (h)) * HTB)
#define PG8_SB(b, h) ((4 + (b) * 2 + (h)) * HTB)
#define PG8_STAGE(bufoff, gbase, voff) do { _Pragma("unroll") for (int _i = 0; _i < 2; ++_i) \
        __builtin_amdgcn_global_load_lds((const unsigned*)((const char*)(gbase) + (voff)[_i]), (LAS unsigned*)(lds + (bufoff) + ldsw + _i * 8192), 16, 0, 0); } while (0)
#define PG8_STAGE_A(bufoff, gbase, h, NX) do { if constexpr (GATHER) { if (NX) { if (h) PG8_STAGE(bufoff, gbase, gvN1); else PG8_STAGE(bufoff, gbase, gvN0); } else { if (h) PG8_STAGE(bufoff, gbase, gvC1); else PG8_STAGE(bufoff, gbase, gvC0); } } \
        else PG8_STAGE(bufoff, (gbase) + (h) * hstep, voffA); } while (0)
#define PG8_LDA(dst, b, h) do { _Pragma("unroll") for (int m = 0; m < 4; ++m) _Pragma("unroll") for (int k = 0; k < 2; ++k) dst[m][k] = *(const LAS bf16x8*)(lds + PG8_SA(b, h) + aoff + m * 2048 + k * 1024); } while (0)
#define PG8_LDB(dst, b, h) do { _Pragma("unroll") for (int n = 0; n < 2; ++n) _Pragma("unroll") for (int k = 0; k < 2; ++k) dst[n][k] = *(const LAS bf16x8*)(lds + PG8_SB(b, h) + boff + n * 2048 + k * 1024); } while (0)
#define PG8_MMA(ai, bj, At, Bt) do { __builtin_amdgcn_s_setprio(1); _Pragma("unroll") for (int m = 0; m < 4; ++m) _Pragma("unroll") for (int n = 0; n < 2; ++n) _Pragma("unroll") for (int k = 0; k < 2; ++k) \
        acc[ai][bj][m][n] = __builtin_amdgcn_mfma_f32_16x16x32_bf16(Bt[n][k], At[m][k], acc[ai][bj][m][n], 0, 0, 0); __builtin_amdgcn_s_setprio(0); } while (0)
#define PG8_WAIT_V(n) asm volatile("s_waitcnt vmcnt(" #n ")" ::: "memory")
#define PG8_WAIT_L(n) asm volatile("s_waitcnt lgkmcnt(" #n ")" ::: "memory")
#define PG8_BAR __builtin_amdgcn_s_barrier()
#define PG8_SCHED __builtin_amdgcn_sched_barrier(0)
    Unit cur, nxt; int ui = 0;
    if (!S.next(0, cur)) return;
    unsigned gvC0[2] = {0u, 0u}, gvC1[2] = {0u, 0u}, gvN0[2] = {0u, 0u}, gvN1[2] = {0u, 0u};
    if constexpr (GATHER) {
#pragma unroll
        for (int i = 0; i < 2; ++i) { const int* rl = rowlist + (size_t)cur.pm * BM;
            gvC0[i] = ((unsigned)rl[stR[i]] * (unsigned)K + (unsigned)stC[i]) * 2u; gvC1[i] = ((unsigned)rl[HALF + stR[i]] * (unsigned)K + (unsigned)stC[i]) * 2u; }
    }
    f32x4 acc[2][2][4][2];
#pragma unroll
    for (int a = 0; a < 2; ++a)
#pragma unroll
        for (int b = 0; b < 2; ++b)
#pragma unroll
            for (int m = 0; m < 4; ++m)
#pragma unroll
                for (int n = 0; n < 2; ++n) acc[a][b][m][n] = (f32x4){0.f, 0.f, 0.f, 0.f};
    bf16x8 At[4][2], B0[2][2], B1[2][2];
    const char* cA = cur.A; const char* cB = cur.B;
    PG8_STAGE(PG8_SB(0, 0), cB, voffB); PG8_STAGE(PG8_SB(0, 1), cB, voffB1); PG8_STAGE_A(PG8_SA(0, 0), cA, 0, false); PG8_STAGE_A(PG8_SA(0, 1), cA, 1, false);
    if (wr == 1) PG8_BAR;
    PG8_WAIT_V(2); PG8_BAR;
    PG8_STAGE(PG8_SB(1, 0), cB + kstep, voffB); PG8_STAGE_A(PG8_SA(1, 0), cA + kstep, 0, false); PG8_STAGE(PG8_SB(1, 1), cB + kstep, voffB1);
    PG8_WAIT_V(6); PG8_BAR;
    for (;;) {
        const bool has_next = S.next(ui + 1, nxt);
        const char* nA = has_next ? nxt.A : cA; const char* nB = has_next ? nxt.B : cB;
        if constexpr (GATHER) {
            if (has_next) {
#pragma unroll
                for (int i = 0; i < 2; ++i) { const int* rl = rowlist + (size_t)nxt.pm * BM;
                    gvN0[i] = ((unsigned)rl[stR[i]] * (unsigned)K + (unsigned)stC[i]) * 2u; gvN1[i] = ((unsigned)rl[HALF + stR[i]] * (unsigned)K + (unsigned)stC[i]) * 2u; }
            } else { gvN0[0] = gvC0[0]; gvN0[1] = gvC0[1]; gvN1[0] = gvC1[0]; gvN1[1] = gvC1[1]; }
        }
        for (int t = 0; t < nt; t += 2) {
            const bool last = (t == nt - 2);
            const char* a1 = cA + (size_t)(t + 1) * kstep;
            const char* a2 = last ? nA : cA + (size_t)(t + 2) * kstep; const char* b2 = last ? nB : cB + (size_t)(t + 2) * kstep;
            const char* a3 = a2 + kstep; const char* b3 = b2 + kstep;
            PG8_LDB(B0, 0, 0); PG8_LDB(B1, 0, 1); PG8_SCHED; PG8_LDA(At, 0, 0); PG8_STAGE_A(PG8_SA(1, 1), a1, 1, false);
            PG8_WAIT_V(8); PG8_WAIT_L(0); PG8_BAR; PG8_MMA(0, 0, At, B0); PG8_MMA(0, 1, At, B1); PG8_BAR; PG8_SCHED;
            PG8_LDA(At, 0, 1); PG8_STAGE(PG8_SB(0, 0), b2, voffB); PG8_STAGE(PG8_SB(0, 1), b2, voffB1); PG8_STAGE_A(PG8_SA(0, 0), a2, 0, last);
            PG8_WAIT_V(8); PG8_WAIT_L(0); PG8_BAR; PG8_MMA(1, 0, At, B0); PG8_MMA(1, 1, At, B1); PG8_BAR; PG8_SCHED;
            PG8_LDB(B0, 1, 0); PG8_LDB(B1, 1, 1); PG8_SCHED; PG8_LDA(At, 1, 0); PG8_STAGE_A(PG8_SA(0, 1), a2, 1, last);
            PG8_WAIT_V(8); PG8_WAIT_L(0); PG8_BAR; PG8_MMA(0, 0, At, B0); PG8_MMA(0, 1, At, B1); PG8_BAR; PG8_SCHED;
            PG8_LDA(At, 1, 1); PG8_STAGE(PG8_SB(1, 0), b3, voffB); PG8_STAGE(PG8_SB(1, 1), b3, voffB1); PG8_STAGE_A(PG8_SA(1, 0), a3, 0, last);
            PG8_WAIT_V(8); PG8_WAIT_L(0); PG8_BAR; PG8_MMA(1, 0, At, B0); PG8_MMA(1, 1, At, B1); PG8_BAR; PG8_SCHED;
        }
        if (wr == 0) PG8_BAR;
        E(acc, cur, wr, wc, fr, fq);
        if (!has_next) break;
#pragma unroll
        for (int a = 0; a < 2; ++a)
#pragma unroll
            for (int b = 0; b < 2; ++b)
#pragma unroll
                for (int m = 0; m < 4; ++m)
#pragma unroll
                    for (int n = 0; n < 2; ++n) acc[a][b][m][n] = (f32x4){0.f, 0.f, 0.f, 0.f};
        cur = nxt; cA = nA; cB = nB; ++ui;
        if constexpr (GATHER) { gvC0[0] = gvN0[0]; gvC0[1] = gvN0[1]; gvC1[0] = gvN1[0]; gvC1[1] = gvN1[1]; }
        if (wr == 1) PG8_BAR;
    }
    PG8_WAIT_V(0);
    PG8_BAR;
#undef PG8_SA
#undef PG8_SB
#undef PG8_STAGE
#undef PG8_STAGE_A
#undef PG8_LDA
#undef PG8_LDB
#undef PG8_MMA
#undef PG8_WAIT_V
#undef PG8_WAIT_L
#undef PG8_BAR
#undef PG8_SCHED
}
}
typedef __attribute__((address_space(1))) unsigned gu32;
#define RLX_AGENT __ATOMIC_RELAXED, __HIP_MEMORY_SCOPE_AGENT
#define XB_TMO      128
#define XB_XCNT(j)  (256  + 64 * (j))
#define XB_XSUB(j)  (1280 + 64 * (j))
#define XB_XGEN(j)  (2304 + 64 * (j))
#define XB_TOP      3328
#define XB_TOPGEN   3392
#define XCD_BAR_WORDS 3456
#define XB_SPIN_CAP (1u << 18)
__device__ __forceinline__ unsigned xb_ld(unsigned* p)              { return __hip_atomic_load(p, __ATOMIC_RELAXED, __HIP_MEMORY_SCOPE_AGENT); }
__device__ __forceinline__ unsigned xb_add(unsigned* p, unsigned v) { return __hip_atomic_fetch_add(p, v, __ATOMIC_RELAXED, __HIP_MEMORY_SCOPE_AGENT); }
__device__ __forceinline__ unsigned xb_xcc_id() { return (unsigned)__builtin_amdgcn_s_getreg((3 << 11) | 20) & 0xFu; }
#define XB_SPIN(cond, bar) do { unsigned _sp = 0; while (cond) { __builtin_amdgcn_s_sleep(1); \
    if ((++_sp & 255u) == 0u) { if (xb_ld(&(bar)[XB_TMO])) break; if (_sp > XB_SPIN_CAP) { atomicAdd(&(bar)[XB_TMO], 1u); break; } } } } while (0)
struct XcdBarrier { unsigned* bar; unsigned x; volatile LAS unsigned* st; };
__device__ __forceinline__ XcdBarrier xcd_barrier_post(unsigned* bar, volatile LAS unsigned* st) {
    XcdBarrier b; b.bar = bar; b.x = xb_xcc_id(); b.st = st;
    if (threadIdx.x == 0) (void)xb_add(&bar[XB_XCNT(b.x)], 1u);
    return b;
}
__device__ __forceinline__ void xcd_barrier_complete(unsigned* bar, unsigned x, unsigned& nloc, unsigned& nx) {
    const unsigned G = gridDim.x * gridDim.y * gridDim.z;
    unsigned sum, cnt, mine, sp = 0u;
    for (;;) {
        sum = 0u; cnt = 0u; mine = 0u;
#pragma unroll
        for (unsigned j = 0; j < 16; ++j) { const unsigned c = xb_ld(&bar[XB_XCNT(j)]); sum += c; cnt += (c > 0u) ? 1u : 0u; mine = (j == x) ? c : mine; }
        if (sum == G) break;
        __builtin_amdgcn_s_sleep(1);
        if ((++sp & 255u) == 0u) { if (xb_ld(&bar[XB_TMO])) break; if (sp > XB_SPIN_CAP) { atomicAdd(&bar[XB_TMO], 1u); break; } }
    }
    nloc = mine > 0u ? mine : 1u; nx = cnt > 0u ? cnt : 1u;
}
__device__ __forceinline__ void xcd_barrier(const XcdBarrier& b) {
    asm volatile("s_waitcnt vmcnt(0)" ::: "memory");
    __syncthreads();
    if (threadIdx.x == 0) {
        unsigned* bar = b.bar;
        __builtin_amdgcn_s_waitcnt(0);
        unsigned nloc = b.st[0], nx = b.st[1];
        if (nloc == 0u) { xcd_barrier_complete(bar, b.x, nloc, nx); b.st[0] = nloc; b.st[1] = nx; }
        const unsigned old = xb_add(&bar[XB_XSUB(b.x)], 1u);
        const unsigned gen = old / nloc;
        if (old + 1u == (gen + 1u) * nloc) {
            __builtin_amdgcn_fence(__ATOMIC_RELEASE, "agent");
            asm volatile("s_waitcnt vmcnt(0)" ::: "memory");
            const unsigned og = xb_add(&bar[XB_TOP], 1u);
            const unsigned tg = og / nx;
            if (og + 1u == (tg + 1u) * nx) xb_add(&bar[XB_TOPGEN], 1u);
            else XB_SPIN(xb_ld(&bar[XB_TOPGEN]) == tg, bar);
            __builtin_amdgcn_fence(__ATOMIC_ACQUIRE, "agent");
            xb_add(&bar[XB_XGEN(b.x)], 1u);
            asm volatile("s_waitcnt vmcnt(0)" ::: "memory");
        } else {
            XB_SPIN(xb_ld(&bar[XB_XGEN(b.x)]) == gen, bar);
            __builtin_amdgcn_fence(__ATOMIC_ACQUIRE, "agent");
            asm volatile("s_waitcnt vmcnt(0)" ::: "memory");
        }
    }
    __syncthreads();
}

constexpr int NWAVES = 8, NTHREADS = 512;
constexpr int RING_BYTES = 131072, LDS_BYTES = 163840, MISC_OFF = LDS_BYTES - 512;
constexpr int CW_BAR = 4096;
constexpr size_t CTL_ZERO_BYTES = 256 * 1024;
struct Args { Ptrs p; int ph_lo, ph_hi; };

struct EpiInProj {
    static constexpr bool PERM = true;
    bf16_t* PROJ; const float* R;
    __device__ __forceinline__ void operator()(const f32x4 (&acc)[2][2][4][2], const pg8::Unit& u, int wr, int wc, int fr, int fq) const {
        const int row0 = u.pm * 256 + wr * 64 + fr, col0 = u.pn * 256 + wc * 64 + 16 * fq;
        const bool qk = (u.pn >= 4 && u.pn < 8), isk = (u.pn >= 6 && u.pn < 8), lat = (u.pm >= NCTX / 256);
#pragma unroll
        for (int ai = 0; ai < 2; ++ai)
#pragma unroll
            for (int m = 0; m < 4; ++m) {
                const int row = row0 + ai * 128 + m * 16; const int cgp = col0 >> 9, cin = col0 & 511;
                bf16_t* rowp = PROJ + (cgp < 2 ? proj_blk(cgp, cin >> 6) + (size_t)row * 64 + (cin & 63) : proj_blk(cgp, cin >> 7) + (size_t)row * 128 + (cin & 127));
                const int t = (row - NCTX) & (T - 1);
#pragma unroll
                for (int bj = 0; bj < 2; ++bj) {
                    f32x4 v0 = acc[ai][bj][m][0], v1 = acc[ai][bj][m][1];
                    if (qk) {
                        if (lat) {
                            const int ip0 = ((col0 + bj * 8) & 127) >> 1, pos = (ip0 < 32) ? (t >> 6) : (t & 63);
                            const f32x4* rp = (const f32x4*)(R + (size_t)(pos * 32 + (ip0 & 31)) * 2);
                            const f32x4 c0 = rp[0], c1 = rp[1];
                            f32x4 w0, w1;
                            w0[0] = v0[0] * c0[0] - v0[1] * c0[1]; w0[1] = v0[0] * c0[1] + v0[1] * c0[0];
                            w0[2] = v0[2] * c0[2] - v0[3] * c0[3]; w0[3] = v0[2] * c0[3] + v0[3] * c0[2];
                            w1[0] = v1[0] * c1[0] - v1[1] * c1[1]; w1[1] = v1[0] * c1[1] + v1[1] * c1[0];
                            w1[2] = v1[2] * c1[2] - v1[3] * c1[3]; w1[3] = v1[2] * c1[3] + v1[3] * c1[2];
                            v0 = w0; v1 = w1;
                        }
                        if (isk) { v0 = v0 * 0.08838834764831845f; v1 = v1 * 0.08838834764831845f; }
                    }
                    pg8::u32x4 w; w.x = pg8::cvt_pk_bf16(v0[0], v0[1]); w.y = pg8::cvt_pk_bf16(v0[2], v0[3]); w.z = pg8::cvt_pk_bf16(v1[0], v1[1]); w.w = pg8::cvt_pk_bf16(v1[2], v1[3]);
                    *(pg8::u32x4*)(rowp + bj * 8) = w;
                }
            }
    }
};
struct EpiOutProj {
    static constexpr bool PERM = true;
    const float* x; const float* MOD; bf16_t* out; float* SSQ;
    __device__ __forceinline__ void operator()(const f32x4 (&acc)[2][2][4][2], const pg8::Unit& u, int wr, int wc, int fr, int fq) const {
        const int row0 = u.pm * 256 + wr * 64 + fr, col0 = u.pn * 256 + wc * 64 + 16 * fq;
        const float* g1 = MOD + (size_t)(u.pm / (T / 256)) * NMOD + 2 * D + col0;
        f32x4 gv[2][2];
#pragma unroll
        for (int bj = 0; bj < 2; ++bj) { gv[bj][0] = *(const f32x4*)(g1 + bj * 8); gv[bj][1] = *(const f32x4*)(g1 + bj * 8 + 4); }
        struct XG { f32x4 v[2][2]; };
        auto ldx = [&](XG& g, int gi) { const size_t off = (size_t)(row0 + (gi >> 2) * 128 + (gi & 3) * 16) * D + col0;
#pragma unroll
            for (int bj = 0; bj < 2; ++bj) { g.v[bj][0] = *(const f32x4*)(x + off + bj * 8); g.v[bj][1] = *(const f32x4*)(x + off + bj * 8 + 4); } };
        auto fin = [&](const XG& g, int gi) { const int ai = gi >> 2, m = gi & 3; const size_t off = (size_t)(row0 + ai * 128 + m * 16) * D + col0; float sq = 0.f;
#pragma unroll
            for (int bj = 0; bj < 2; ++bj) {
                const f32x4 o0 = g.v[bj][0] + gv[bj][0] * acc[ai][bj][m][0], o1 = g.v[bj][1] + gv[bj][1] * acc[ai][bj][m][1];
                pg8::u32x4 ob; ob.x = pg8::cvt_pk_bf16(o0[0], o0[1]); ob.y = pg8::cvt_pk_bf16(o0[2], o0[3]); ob.z = pg8::cvt_pk_bf16(o1[0], o1[1]); ob.w = pg8::cvt_pk_bf16(o1[2], o1[3]);
                *(pg8::u32x4*)(out + off + bj * 8) = ob;
                sq += o0[0] * o0[0] + o0[1] * o0[1] + o0[2] * o0[2] + o0[3] * o0[3] + o1[0] * o1[0] + o1[1] * o1[1] + o1[2] * o1[2] + o1[3] * o1[3];
            }
            sq += __shfl_xor(sq, 16); sq += __shfl_xor(sq, 32);
            if (fq == 0) SSQ[(size_t)(row0 + ai * 128 + m * 16) * 16 + u.pn * 4 + wc] = sq; };
        XG a, b, c;
        ldx(a, 0); ldx(b, 1); ldx(c, 2);
        fin(a, 0); ldx(a, 3); fin(b, 1); ldx(b, 4); fin(c, 2); ldx(c, 5);
        fin(a, 3); ldx(a, 6); fin(b, 4); ldx(b, 7); fin(c, 5);
        fin(a, 6); fin(b, 7);
    }
};

struct MoeOrderGU {
    const char* H2; const char* W; const int* tile_e; int n0, n1, G, c;
    __device__ bool next(int i, pg8::Unit& u) const {
        int ri, pn;
        if ((G & 63) == 0) { const int x = c & 7, slot = c >> 3, rpg = G >> 4; ri = (i * 8 + x) * rpg + (slot >> 1); pn = slot & 1; }
        else { const int L = i * G + c; ri = L >> 1; pn = L & 1; }
        if (ri >= n0 + n1 + 256) return false;
        int q = 0; if (ri >= n0 + 128) { q = 1; ri -= n0 + 128; }
        const int nq = q ? n1 : n0, rt = (ri < nq) ? ri : RT_ROUTED + (ri - nq), e = (ri < nq) ? tile_e[q * RT_PART + rt] : NE;
        u.pm = q * RT_PART + rt; u.pn = pn; u.aux = e; u.pad = 0; u.A = H2; u.B = W + (size_t)e * (512 * 1024 * 2) + (size_t)pn * (256 * 1024 * 2); return true;
    }
};
struct MoeOrderDown {
    const char* HB; const char* W; const int* tile_e; int n0, n1, G, c;
    __device__ bool next(int i, pg8::Unit& u) const {
        int ri, pn;
        if ((G & 63) == 0) { const int x = c & 7, slot = c >> 3, rpg = G >> 5; ri = (i * 8 + x) * rpg + (slot >> 2); pn = slot & 3; }
        else { const int L = i * G + c; ri = L >> 2; pn = L & 3; }
        if (ri >= n0 + n1 + 256) return false;
        ri = n0 + n1 + 255 - ri;
        int q = 0; if (ri >= n0 + 128) { q = 1; ri -= n0 + 128; }
        const int nq = q ? n1 : n0, rt = (ri < nq) ? ri : RT_ROUTED + (ri - nq), e = (ri < nq) ? tile_e[q * RT_PART + rt] : NE;
        u.pm = q * RT_PART + rt; u.pn = pn; u.aux = e; u.pad = 0; u.A = HB + (size_t)u.pm * (256 * 256 * 2); u.B = W + (size_t)e * (1024 * 256 * 2) + (size_t)pn * (256 * 256 * 2); return true;
    }
};
struct EpiGateUp {
    static constexpr bool PERM = true;
    bf16_t* HB;
    __device__ __forceinline__ void operator()(const f32x4 (&acc)[2][2][4][2], const pg8::Unit& u, int wr, int wc, int fr, int fq) const {
        const int row0 = u.pm * 256 + wr * 64 + fr, hcol = u.pn * 128 + wc * 32 + 8 * fq;
#pragma unroll
        for (int ai = 0; ai < 2; ++ai)
#pragma unroll
            for (int m = 0; m < 4; ++m) {
                bf16_t* rowp = HB + (size_t)(row0 + ai * 128 + m * 16) * DE + hcol;
                pg8::u32x4 w4;
#pragma unroll
                for (int bj = 0; bj < 2; ++bj) {
                    const f32x4 g = acc[ai][bj][m][0], uu = acc[ai][bj][m][1]; f32x4 h;
#pragma unroll
                    for (int j = 0; j < 4; ++j) h[j] = g[j] * __builtin_amdgcn_rcpf(1.f + __builtin_amdgcn_exp2f(-1.4426950408889634f * g[j])) * uu[j];
                    w4[2 * bj] = pg8::cvt_pk_bf16(h[0], h[1]); w4[2 * bj + 1] = pg8::cvt_pk_bf16(h[2], h[3]);
                }
                *(pg8::u32x4*)rowp = w4;
            }
    }
};
struct EpiDown {
    static constexpr bool PERM = true;
    unsigned char* YT;
    __device__ __forceinline__ void operator()(const f32x4 (&acc)[2][2][4][2], const pg8::Unit& u, int wr, int wc, int fr, int fq) const {
        const int row0 = u.pm * 256 + wr * 64 + fr, col0 = u.pn * 256 + wc * 64 + 16 * fq;
#pragma unroll
        for (int ai = 0; ai < 2; ++ai)
#pragma unroll
            for (int m = 0; m < 4; ++m) {
                pg8::u32x4 o;
#pragma unroll
                for (int bj = 0; bj < 2; ++bj) {
                    f32x4 v0 = acc[ai][bj][m][0] * 16.f, v1 = acc[ai][bj][m][1] * 16.f;
#pragma unroll
                    for (int j = 0; j < 4; ++j) { v0[j] = fminf(fmaxf(v0[j], -448.f), 448.f); v1[j] = fminf(fmaxf(v1[j], -448.f), 448.f); }
                    int w0 = __builtin_amdgcn_cvt_pk_fp8_f32(v0[0], v0[1], 0, false); w0 = __builtin_amdgcn_cvt_pk_fp8_f32(v0[2], v0[3], w0, true);
                    int w1 = __builtin_amdgcn_cvt_pk_fp8_f32(v1[0], v1[1], 0, false); w1 = __builtin_amdgcn_cvt_pk_fp8_f32(v1[2], v1[3], w1, true);
                    o[2 * bj] = (unsigned)w0; o[2 * bj + 1] = (unsigned)w1;
                }
                *(pg8::u32x4*)(YT + (size_t)(row0 + ai * 128 + m * 16) * D + col0) = o;
            }
    }
};

typedef float f32x16 __attribute__((ext_vector_type(16)));
constexpr size_t WS_SNAP = WS_HF;
typedef short v4i16_t __attribute__((ext_vector_type(4)));
__device__ __forceinline__ v4i16_t tr16(const LAS bf16_t* p) { return __builtin_amdgcn_ds_read_tr16_b64_v4i16((LAS v4i16_t*)p); }
__device__ __forceinline__ pg8::bf16x8 cat8(v4i16_t a, v4i16_t b) { return __builtin_shufflevector(a, b, 0, 1, 2, 3, 4, 5, 6, 7); }
__device__ __forceinline__ size_t snap_off(int dv, int dk) { return ((size_t)(dk >> 4) * 128 + dv) * 16 + (dk & 15); }
__device__ __forceinline__ void ret_state_walk(const Ptrs& p, LAS unsigned char* lds, int unit) {
    const int tid = threadIdx.x, lane = tid & 63, w = __builtin_amdgcn_readfirstlane(tid >> 6), fr = lane & 15, fq = lane >> 4, tq = (lane & 15) >> 2, tp = lane & 3;
    const int dvh = unit & 1, dir = (unit >> 1) & 1, hd = (unit >> 2) & 3, b = unit >> 4;
    const float lg = ret_logg(hd), gC = __expf(128.f * lg);
    constexpr int WBUF = 128 * 272 + 128 * 144;
    const bf16_t* PROJ = (const bf16_t*)(p.ws + WS_PROJ);
    bf16_t* SN = (bf16_t*)(p.ws + WS_SNAP) + ((size_t)((b * NH + hd) * 2 + dir) * 32) * 16384;
    f32x4 acc[4];
#pragma unroll
    for (int n = 0; n < 4; ++n) acc[n] = (f32x4){0.f, 0.f, 0.f, 0.f};
    __syncthreads();
    u16x8 kreg[4], vreg[2];
    auto chunk_row0 = [&](int step) -> size_t { if (step < 2) { const int cc = dir == 0 ? step : 1 - step; return (size_t)b * LC + cc * 128; } const int n = dir == 0 ? step - 2 : 31 - (step - 2); return (size_t)NCTX + (size_t)b * T + n * 128; };
    auto prefetch = [&](int step) {
        const size_t r0 = chunk_row0(step);
#pragma unroll
        for (int i = 0; i < 4; ++i) { const int idx = tid + 512 * i, tok = idx >> 4, c = idx & 15; kreg[i] = *(const u16x8*)(PROJ + proj_blk(3, hd) + (r0 + tok) * 128 + c * 8); }
#pragma unroll
        for (int i = 0; i < 2; ++i) { const int idx = tid + 512 * i, tok = idx >> 3, c = idx & 7; vreg[i] = *(const u16x8*)(PROJ + proj_blk(4, hd) + (r0 + tok) * 128 + dvh * 64 + c * 8); }
    };
    prefetch(0);
    for (int step = 0; step < 34; ++step) {
        LAS bf16_t* KL = (LAS bf16_t*)(lds + (step & 1) * WBUF);
        LAS bf16_t* VL = (LAS bf16_t*)(lds + (step & 1) * WBUF + 128 * 272);
#pragma unroll
        for (int i = 0; i < 4; ++i) { const int idx = tid + 512 * i, tok = idx >> 4, c = idx & 15; *(LAS u16x8*)(KL + tok * 136 + c * 8) = kreg[i]; }
#pragma unroll
        for (int i = 0; i < 2; ++i) { const int idx = tid + 512 * i, tok = idx >> 3, c = idx & 7; const float wt = __expf((float)(dir == 0 ? 127 - tok : tok) * lg);
            pg8::u32x4 o; o.x = pg8::cvt_pk_bf16(bf2f(vreg[i][0]) * wt, bf2f(vreg[i][1]) * wt); o.y = pg8::cvt_pk_bf16(bf2f(vreg[i][2]) * wt, bf2f(vreg[i][3]) * wt);
            o.z = pg8::cvt_pk_bf16(bf2f(vreg[i][4]) * wt, bf2f(vreg[i][5]) * wt); o.w = pg8::cvt_pk_bf16(bf2f(vreg[i][6]) * wt, bf2f(vreg[i][7]) * wt);
            *(LAS pg8::u32x4*)(VL + tok * 72 + c * 8) = o; }
        if (step + 1 < 34) prefetch(step + 1);
        if (step >= 2) {
            const int n = dir == 0 ? step - 2 : 31 - (step - 2);
            bf16_t* dst = SN + (size_t)n * 16384;
#pragma unroll
            for (int nn = 0; nn < 4; ++nn) { pg8::u32x2 o; o.x = pg8::cvt_pk_bf16(acc[nn][0], acc[nn][1]); o.y = pg8::cvt_pk_bf16(acc[nn][2], acc[nn][3]);
                *(pg8::u32x2*)(dst + snap_off(dvh * 64 + 16 * nn + fr, 16 * w + 4 * fq)) = o; }
        }
#pragma unroll
        for (int nn = 0; nn < 4; ++nn) acc[nn] = acc[nn] * gC;
        __syncthreads();
#pragma unroll
        for (int s4 = 0; s4 < 4; ++s4) {
            const int tb = 32 * s4 + 8 * fq + tq;
            const pg8::bf16x8 a = cat8(tr16(KL + tb * 136 + 16 * w + 4 * tp), tr16(KL + (tb + 4) * 136 + 16 * w + 4 * tp));
#pragma unroll
            for (int nn = 0; nn < 4; ++nn) { const pg8::bf16x8 bb = cat8(tr16(VL + tb * 72 + 16 * nn + 4 * tp), tr16(VL + (tb + 4) * 72 + 16 * nn + 4 * tp)); acc[nn] = __builtin_amdgcn_mfma_f32_16x16x32_bf16(a, bb, acc[nn], 0, 0, 0); }
        }
    }
    __syncthreads();
}
__device__ __forceinline__ void ret_chunk_out(const Ptrs& p, LAS unsigned char* lds, int unit) {
    const int tid = threadIdx.x, lane = tid & 63, w = __builtin_amdgcn_readfirstlane(tid >> 6), r = lane & 31, h = lane >> 5, blk = (lane >> 4) & 1, tq = (lane & 15) >> 2, tp = lane & 3;
    const int n = unit & 31, hd = (unit >> 5) & 3, b = unit >> 7, qb = w & 3, dvh = w >> 2;
    const float lg = ret_logg(hd);
    LAS bf16_t* KL = (LAS bf16_t*)lds;
    LAS bf16_t* VL = (LAS bf16_t*)(lds + 128 * 272);
    LAS float* RS = (LAS float*)(lds + 2 * 128 * 272);
    const size_t crow = (size_t)NCTX + (size_t)b * T + (size_t)n * 128;
    const bf16_t* PJ = (const bf16_t*)(p.ws + WS_PROJ);
    const bf16_t* Qb = PJ + proj_blk(2, hd) + crow * 128; const bf16_t* Kb = PJ + proj_blk(3, hd) + crow * 128; const bf16_t* Vb = PJ + proj_blk(4, hd) + crow * 128; const bf16_t* Gb = PJ + proj_blk(5, hd) + crow * 128;
    __syncthreads();
#pragma unroll
    for (int i = 0; i < 4; ++i) { const int idx = tid + 512 * i, tok = idx >> 4, c = idx & 15;
        const u16x8 kv = *(const u16x8*)(Kb + tok * 128 + c * 8); *(LAS u16x8*)(KL + tok * 136 + c * 8) = kv;
        const u16x8 vv = *(const u16x8*)(Vb + tok * 128 + c * 8); *(LAS u16x8*)(VL + tok * 136 + c * 8) = vv; }
    pg8::bf16x8 qf[8];
#pragma unroll
    for (int s = 0; s < 8; ++s) qf[s] = *(const pg8::bf16x8*)(Qb + (qb * 32 + r) * 128 + 16 * s + 8 * h);
    f32x16 Z[2];
#pragma unroll
    for (int t = 0; t < 2; ++t)
#pragma unroll
        for (int e = 0; e < 16; ++e) Z[t][e] = 0.f;
    const bf16_t* SNf = (const bf16_t*)(p.ws + WS_SNAP) + ((size_t)((b * NH + hd) * 2 + 0) * 32 + n) * 16384;
    const bf16_t* SNb = SNf + (size_t)32 * 16384;
#pragma unroll
    for (int t = 0; t < 2; ++t)
#pragma unroll
        for (int s = 0; s < 8; ++s) { const pg8::bf16x8 sf = *(const pg8::bf16x8*)(SNf + snap_off(dvh * 64 + t * 32 + r, 16 * s + 8 * h)); Z[t] = __builtin_amdgcn_mfma_f32_32x32x16_bf16(qf[s], sf, Z[t], 0, 0, 0); }
#pragma unroll
    for (int e = 0; e < 16; ++e) { const int i = qb * 32 + (e & 3) + 8 * (e >> 2) + 4 * h; const float ratio = __expf((float)(2 * i + 1 - 128) * lg); Z[0][e] *= ratio; Z[1][e] *= ratio; }
#pragma unroll
    for (int t = 0; t < 2; ++t)
#pragma unroll
        for (int s = 0; s < 8; ++s) { const pg8::bf16x8 sb = *(const pg8::bf16x8*)(SNb + snap_off(dvh * 64 + t * 32 + r, 16 * s + 8 * h)); Z[t] = __builtin_amdgcn_mfma_f32_32x32x16_bf16(qf[s], sb, Z[t], 0, 0, 0); }
#pragma unroll
    for (int e = 0; e < 16; ++e) { const int i = qb * 32 + (e & 3) + 8 * (e >> 2) + 4 * h; const float xb = __expf((float)(128 - i) * lg); Z[0][e] *= xb; Z[1][e] *= xb; }
    __syncthreads();
    for (int kb = 0; kb < 4; ++kb) {
        f32x16 X;
#pragma unroll
        for (int e = 0; e < 16; ++e) X[e] = 0.f;
#pragma unroll
        for (int s = 0; s < 8; ++s) { const pg8::bf16x8 a = *(const LAS pg8::bf16x8*)(KL + (32 * kb + r) * 136 + 16 * s + 8 * h); X = __builtin_amdgcn_mfma_f32_32x32x16_bf16(a, qf[s], X, 0, 0, 0); }
        const int iq = qb * 32 + r;
#pragma unroll
        for (int e = 0; e < 16; ++e) { const int j = 32 * kb + (e & 3) + 8 * (e >> 2) + 4 * h; const int dd = iq > j ? iq - j : j - iq; X[e] *= __expf((float)dd * lg); }
        pg8::bf16x8 pa[2];
#pragma unroll
        for (int s2 = 0; s2 < 2; ++s2) { pg8::u32x4 t4; t4.x = pg8::cvt_pk_bf16(X[8 * s2 + 0], X[8 * s2 + 1]); t4.y = pg8::cvt_pk_bf16(X[8 * s2 + 2], X[8 * s2 + 3]); t4.z = pg8::cvt_pk_bf16(X[8 * s2 + 4], X[8 * s2 + 5]); t4.w = pg8::cvt_pk_bf16(X[8 * s2 + 6], X[8 * s2 + 7]);
            pa[s2] = __builtin_bit_cast(pg8::bf16x8, t4); }
#pragma unroll
        for (int t = 0; t < 2; ++t)
#pragma unroll
            for (int s2 = 0; s2 < 2; ++s2) {
                const LAS bf16_t* vp = VL + (32 * kb + 16 * s2 + 4 * h + tq) * 136 + dvh * 64 + t * 32 + 16 * blk + 4 * tp;
                const pg8::bf16x8 vb = cat8(tr16(vp), tr16(vp + 8 * 136));
                Z[t] = __builtin_amdgcn_mfma_f32_32x32x16_bf16(pa[s2], vb, Z[t], 0, 0, 0);
            }
    }
    float rs[16];
#pragma unroll
    for (int e = 0; e < 16; ++e) { float v = Z[0][e] * Z[0][e] + Z[1][e] * Z[1][e];
        v += __shfl_xor(v, 1); v += __shfl_xor(v, 2); v += __shfl_xor(v, 4); v += __shfl_xor(v, 8); v += __shfl_xor(v, 16); rs[e] = v; }
    if (r == 0) {
#pragma unroll
        for (int e = 0; e < 16; ++e) RS[dvh * 128 + qb * 32 + (e & 3) + 8 * (e >> 2) + 4 * h] = rs[e];
    }
    __syncthreads();
    bf16_t* Y = (bf16_t*)(p.ws + WS_Y) + ((size_t)b * T + (size_t)n * 128) * D + DL + hd * 128;
    unsigned short gv[2][16];
#pragma unroll
    for (int e = 0; e < 16; ++e) { const int row = qb * 32 + (e & 3) + 8 * (e >> 2) + 4 * h;
#pragma unroll
        for (int t = 0; t < 2; ++t) gv[t][e] = Gb[(unsigned)(row * 128 + dvh * 64 + t * 32 + r)]; }
#pragma unroll
    for (int e = 0; e < 16; ++e) {
        const int row = qb * 32 + (e & 3) + 8 * (e >> 2) + 4 * h;
        const float rstd = rsqrtf((RS[row] + RS[128 + row]) * (1.f / 128.f) + EPS);
#pragma unroll
        for (int t = 0; t < 2; ++t) { const int dv = dvh * 64 + t * 32 + r; const float g = bf2f(gv[t][e]); const float yv = Z[t][e] * rstd * (g * __builtin_amdgcn_rcpf(1.f + __builtin_amdgcn_exp2f(-1.4426950408889634f * g)));
            Y[(unsigned)(row * D + dv)] = (unsigned short)pg8::cvt_pk_bf16(yv, yv); }
    }
}

constexpr size_t WS_SSQ = 7 * MiB;
constexpr size_t WS_WRT = 125 * MiB;
constexpr size_t WS_WLRU = 124 * MiB;
constexpr size_t WS_HFB = 928 * MiB;
__device__ __forceinline__ void lru_unit(const Ptrs& p, LAS unsigned char* lds, int unit) {
    const int tid = threadIdx.x, lane = tid & 63, w = __builtin_amdgcn_readfirstlane(tid >> 6), r = lane & 31, h = lane >> 5;
    const int nh = unit & 1, hb = (unit >> 1) & 7, b = unit >> 4;
    const int ch = hb * 64 + nh * 32 + r;
    LAS float* cwl = (LAS float*)lds;
    LAS float* comp = (LAS float*)(lds + 2048);
    const bf16_t* PROJ = (const bf16_t*)(p.ws + WS_PROJ);
    bf16_t* HF = (bf16_t*)(p.ws + WS_HFB);
    bf16_t* Y = (bf16_t*)(p.ws + WS_Y);
    __syncthreads();
    if (tid < 320) { const int k = tid >> 6, c = tid & 63; cwl[tid] = (k < 4) ? p.conv_w[k * DL + hb * 64 + c] : p.conv_b[hb * 64 + c]; }
    __syncthreads();
    for (int dir = 0; dir < 2; ++dir) {
        const bf16_t* WL = (const bf16_t*)(p.ws + WS_WLRU) + ((size_t)(dir * NBLK + hb) * 2) * 4096;
        LAS bf16_t* wl = (LAS bf16_t*)(lds + 147456);
        __syncthreads();
        { const int gate = tid >> 8, o = (tid >> 3) & 31, c = tid & 7; *(LAS u16x8*)(wl + (gate * 32 + o) * 72 + c * 8) = *(const u16x8*)(WL + (size_t)gate * 4096 + (size_t)(nh * 32 + o) * 64 + c * 8); }
        const float br = p.lru_b_rec[dir * DL + ch], bi = p.lru_b_in[dir * DL + ch];
        const float cch = -8.f * log1pf(__expf(-p.lru_lambda[dir * DL + ch])) * 1.4426950408889634f;
        float round_carry = 0.f;
        auto fetch_xa = [&](int sgx, int par) {
            const bool ic = sgx < 4; const int tlx = ic ? (dir == 0 ? sgx : 3 - sgx) : (dir == 0 ? sgx - 4 : 63 - (sgx - 4)), t0x = tlx * 64, lenx = ic ? LC : T;
            const size_t rbx = ic ? (size_t)b * LC : (size_t)NCTX + (size_t)b * T;
            LAS bf16_t* xd = (LAS bf16_t*)(lds + 8192 + (w * 2 + par) * 8704);
#pragma unroll
            for (int i = 0; i < 9; ++i) { const int row = 8 * i + (lane >> 3); int tt = t0x - 2 + row; tt = tt < 0 ? 0 : (tt >= lenx ? lenx - 1 : tt);
                if (row < 67) __builtin_amdgcn_global_load_lds((const unsigned*)(PROJ + proj_blk(0, hb) + (rbx + tt) * 64 + (((lane & 7) ^ ((lane >> 3) & 7)) * 8)), (LAS unsigned*)(xd + i * 512), 16, 0, 0); }
        };
        __syncthreads();
        fetch_xa(w, 0);
        for (int rd = 0; rd < 9; ++rd) {
            const int sg = rd * 8 + w; const bool active = sg < 68;
            f32x16 P[2], Q[2]; float Ap = 1.f, Bp = 0.f;
            bool is_ctx = false; int t0 = 0;
            if (active) {
                is_ctx = sg < 4; const int tl = is_ctx ? (dir == 0 ? sg : 3 - sg) : (dir == 0 ? sg - 4 : 63 - (sg - 4)); t0 = tl * 64;
                const int len = is_ctx ? LC : T; const size_t rowbase = is_ctx ? (size_t)b * LC : (size_t)NCTX + (size_t)b * T;
                LAS bf16_t* xt = (LAS bf16_t*)(lds + 8192 + (w * 2 + (rd & 1)) * 8704);
                if (sg + 8 < 68) { fetch_xa(sg + 8, (rd + 1) & 1); asm volatile("s_waitcnt vmcnt(9)" ::: "memory"); }
                else asm volatile("s_waitcnt vmcnt(0)" ::: "memory");
                if (t0 == 0 && lane < 16) *(LAS u16x8*)(xt + lane * 8) = (u16x8){0, 0, 0, 0, 0, 0, 0, 0};
                if (t0 + 64 == len && lane < 8) *(LAS u16x8*)(xt + 66 * 64 + lane * 8) = (u16x8){0, 0, 0, 0, 0, 0, 0, 0};
                asm volatile("s_waitcnt lgkmcnt(0)" ::: "memory");
#pragma unroll
                for (int m = 0; m < 2; ++m) {
                    const int rho = 32 * m + r, trow = dir == 0 ? rho : 63 - rho;
                    pg8::bf16x8 af[4];
#pragma unroll
                    for (int s4 = 0; s4 < 4; ++s4) {
                        const int c0 = 16 * s4 + 8 * h; float u8[8];
                        { const f32x4 b0 = *(const LAS f32x4*)(cwl + 256 + c0), b1 = *(const LAS f32x4*)(cwl + 256 + c0 + 4); u8[0] = b0[0]; u8[1] = b0[1]; u8[2] = b0[2]; u8[3] = b0[3]; u8[4] = b1[0]; u8[5] = b1[1]; u8[6] = b1[2]; u8[7] = b1[3]; }
#pragma unroll
                        for (int d = 0; d < 4; ++d) { const int xrow = trow + d; const u16x8 xv = *(const LAS u16x8*)(xt + xrow * 64 + (((c0 >> 3) ^ (xrow & 7)) << 3));
                            const f32x4 w0 = *(const LAS f32x4*)(cwl + d * 64 + c0), w1 = *(const LAS f32x4*)(cwl + d * 64 + c0 + 4);
#pragma unroll
                            for (int j = 0; j < 4; ++j) { u8[j] += w0[j] * bf2f(xv[j]); u8[4 + j] += w1[j] * bf2f(xv[4 + j]); } }
                        pg8::u32x4 t4; t4.x = pg8::cvt_pk_bf16(u8[0], u8[1]); t4.y = pg8::cvt_pk_bf16(u8[2], u8[3]); t4.z = pg8::cvt_pk_bf16(u8[4], u8[5]); t4.w = pg8::cvt_pk_bf16(u8[6], u8[7]);
                        af[s4] = __builtin_bit_cast(pg8::bf16x8, t4);
                    }
                    f32x16 R, I, U;
#pragma unroll
                    for (int e = 0; e < 16; ++e) { R[e] = 0.f; I[e] = 0.f; U[e] = 0.f; }
#pragma unroll
                    for (int s4 = 0; s4 < 4; ++s4) { const pg8::bf16x8 wrf = *(const LAS pg8::bf16x8*)(wl + r * 72 + 16 * s4 + 8 * h), wif = *(const LAS pg8::bf16x8*)(wl + (32 + r) * 72 + 16 * s4 + 8 * h);
                        R = __builtin_amdgcn_mfma_f32_32x32x16_bf16(af[s4], wrf, R, 0, 0, 0); I = __builtin_amdgcn_mfma_f32_32x32x16_bf16(af[s4], wif, I, 0, 0, 0); }
                    pg8::bf16x8 idf[2];
                    { int lr = lane; asm volatile("" : "+v"(lr)); const int r_ = lr & 31, h_ = lr >> 5;
#pragma unroll
                      for (int sp = 0; sp < 2; ++sp)
#pragma unroll
                          for (int j = 0; j < 8; ++j) idf[sp][j] = (16 * sp + 8 * h_ + j == r_) ? (short)0x3F80 : (short)0; }
                    if (nh == 0) { U = __builtin_amdgcn_mfma_f32_32x32x16_bf16(af[0], idf[0], U, 0, 0, 0); U = __builtin_amdgcn_mfma_f32_32x32x16_bf16(af[1], idf[1], U, 0, 0, 0); }
                    else         { U = __builtin_amdgcn_mfma_f32_32x32x16_bf16(af[2], idf[0], U, 0, 0, 0); U = __builtin_amdgcn_mfma_f32_32x32x16_bf16(af[3], idf[1], U, 0, 0, 0); }
                    float Ar[4], Br[4];
#pragma unroll
                    for (int g = 0; g < 4; ++g) {
                        float pp = 1.f, qq = 0.f;
#pragma unroll
                        for (int e4 = 0; e4 < 4; ++e4) { const int e = 4 * g + e4;
                            const float rs = __builtin_amdgcn_rcpf(1.f + __builtin_amdgcn_exp2f(-1.4426950408889634f * (R[e] + br)));
                            const float is = __builtin_amdgcn_rcpf(1.f + __builtin_amdgcn_exp2f(-1.4426950408889634f * (I[e] + bi)));
                            const float a = __builtin_amdgcn_exp2f(cch * rs);
                            const float bb = __builtin_amdgcn_sqrtf(fmaxf(1.f - a * a, 0.f)) * (is * U[e]);
                            pp = a * pp; qq = a * qq + bb; P[m][e] = pp; Q[m][e] = qq; }
                        Ar[g] = pp; Br[g] = qq;
                    }
#pragma unroll
                    for (int g = 0; g < 4; ++g) {
                        const float Ao = __shfl_xor(Ar[g], 32), Bo = __shfl_xor(Br[g], 32);
                        const float A0 = h == 0 ? Ar[g] : Ao, B0 = h == 0 ? Br[g] : Bo, A1 = h == 0 ? Ao : Ar[g], B1 = h == 0 ? Bo : Br[g];
                        const float Am = A0 * Ap, Bm = A0 * Bp + B0;
                        const float Aq = h == 0 ? Ap : Am, Bq = h == 0 ? Bp : Bm;
#pragma unroll
                        for (int e4 = 0; e4 < 4; ++e4) { const int e = 4 * g + e4; const float pe = P[m][e]; Q[m][e] = pe * Bq + Q[m][e]; P[m][e] = pe * Aq; }
                        Ap = A1 * Am; Bp = A1 * Bm + B1;
                    }
                }
            }
            LAS float* cb = comp + (rd & 1) * 512;
            if (h == 0) { cb[(w * 32 + r) * 2] = Ap; cb[(w * 32 + r) * 2 + 1] = Bp; }
            __syncthreads();
            float st = round_carry, mine = 0.f;
#pragma unroll
            for (int ww = 0; ww < 8; ++ww) { const float A = cb[(ww * 32 + r) * 2], Bv = cb[(ww * 32 + r) * 2 + 1]; if (ww == w) mine = st; st = A * st + Bv; }
            round_carry = st;
            if (active && !is_ctx) {
                const int tl0 = dir == 0 ? t0 + 4 * h : t0 + 63 - 4 * h, sgn = dir == 0 ? 1 : -1;
                unsigned short* HFb = HF + (size_t)b * T * DL; const bf16_t* GAb = PROJ + proj_blk(1, hb) + ((size_t)NCTX + (size_t)b * T) * 64; bf16_t* Yb = Y + (size_t)b * T * D;
                if (dir == 0) {
#pragma unroll
                    for (int m = 0; m < 2; ++m)
#pragma unroll
                        for (int e = 0; e < 16; ++e) { const int tok = tl0 + sgn * (32 * m + (e & 3) + 8 * (e >> 2)); const float hv = P[m][e] * mine + Q[m][e];
                            HFb[(unsigned)(tok * DL + ch)] = (unsigned short)pg8::cvt_pk_bf16(hv, hv); }
                } else {
#pragma unroll
                    for (int m = 0; m < 2; ++m) {
                        unsigned short hfv[16], gav[16];
#pragma unroll
                        for (int e = 0; e < 16; ++e) { const int tok = tl0 + sgn * (32 * m + (e & 3) + 8 * (e >> 2)); hfv[e] = HFb[(unsigned)(tok * DL + ch)]; gav[e] = GAb[(unsigned)(tok * 64 + (ch & 63))]; }
#pragma unroll
                        for (int e = 0; e < 16; ++e) { const int tok = tl0 + sgn * (32 * m + (e & 3) + 8 * (e >> 2)); const float hv = P[m][e] * mine + Q[m][e];
                            const float ga = bf2f(gav[e]);
                            const float uu = 0.7978845608028654f * (ga + 0.044715f * ga * ga * ga), th = 1.f - 2.f * __builtin_amdgcn_rcpf(1.f + __builtin_amdgcn_exp2f(2.f * 1.4426950408889634f * uu));
                            const float yv = (bf2f(hfv[e]) + hv) * (0.5f * ga * (1.f + th));
                            Yb[(unsigned)(tok * D + ch)] = (unsigned short)pg8::cvt_pk_bf16(yv, yv); }
                    }
                }
            }
        }
        __syncthreads();
        asm volatile("s_waitcnt vmcnt(0)" ::: "memory");
        __syncthreads();
    }
}
struct TItem { const float* src; const float* src2; bf16_t* dst; int K, N, ld, mode, item; };
__device__ __forceinline__ void p0_item_load(const TItem& t, int lane, f32x4 (&v)[8], int& nl0, int& nls) {
    const int nblk = t.N / 32, kb = t.item / nblk, nb = t.item % nblk, k0 = 64 * kb, n0 = 32 * nb, c = lane & 7;
    const float* src = t.src; int col = n0 + 4 * c; nl0 = 4 * c; nls = 1;
    if (t.mode == 1) { const int grp = n0 >> 9; if (grp == 2 || grp == 3) { const int hh = (n0 & 511) >> 7, ip0 = (n0 & 127) >> 1, s1 = c >> 2, i0 = 4 * (c & 3);
            const int d = (ip0 < 32) ? (ip0 + i0 + 32 * s1) : (64 + (ip0 - 32) + i0 + 32 * s1); col = (grp << 9) + hh * 128 + d; nl0 = 2 * i0 + s1; nls = 2; } }
    if (t.mode == 2) { col = 4 * (n0 >> 3) + 4 * (c >> 1); if (c & 1) src = t.src2; }
#pragma unroll
    for (int i = 0; i < 8; ++i) v[i] = *(const f32x4*)(src + (size_t)(k0 + 8 * i + (lane >> 3)) * t.ld + col);
}
__device__ __forceinline__ void p0_item_store(const TItem& t, int lane, const f32x4 (&v)[8], int nl0, int nls, LAS float* scr) {
    const int nblk = t.N / 32, kb = t.item / nblk, nb = t.item % nblk, k0 = 64 * kb, n0 = 32 * nb;
#pragma unroll
    for (int i = 0; i < 8; ++i) { const int kk = 8 * i + (lane >> 3);
#pragma unroll
        for (int j = 0; j < 4; ++j) scr[kk * 33 + nl0 + nls * j] = v[i][j]; }
    asm volatile("s_waitcnt lgkmcnt(0)" ::: "memory");
    const int c = lane & 7;
#pragma unroll
    for (int j = 0; j < 4; ++j) { const int nn = (lane >> 3) + 8 * j; const LAS float* sp = scr + (8 * c) * 33 + nn;
        pg8::u32x4 o; o.x = pg8::cvt_pk_bf16(sp[0 * 33], sp[1 * 33]); o.y = pg8::cvt_pk_bf16(sp[2 * 33], sp[3 * 33]); o.z = pg8::cvt_pk_bf16(sp[4 * 33], sp[5 * 33]); o.w = pg8::cvt_pk_bf16(sp[6 * 33], sp[7 * 33]);
        *(pg8::u32x4*)(t.dst + (size_t)(n0 + nn) * t.K + k0 + 8 * c) = o; }
    asm volatile("s_waitcnt lgkmcnt(0)" ::: "memory");
}
__device__ __forceinline__ bool p0_item_decode(const Ptrs& p, int it, TItem& t) {
    constexpr int I_IN = (D / 64) * (NPROJ / 32), I_OUT = (D / 64) * (D / 32), I_GU = (D / 64) * (512 / 32), I_DN = (DE / 64) * (D / 32);
    constexpr int NITEMS = I_IN + I_OUT + (NE + 1) * (I_GU + I_DN);
    if (it >= NITEMS) return false;
    int r = it; t.src2 = nullptr;
    if (r < I_IN) { t.src = p.w_in; t.dst = (bf16_t*)(p.ws + WS_WINT); t.K = D; t.N = NPROJ; t.ld = NPROJ; t.mode = 1; t.item = r; return true; } r -= I_IN;
    if (r < I_OUT) { t.src = p.w_out; t.dst = (bf16_t*)(p.ws + WS_WOUTT); t.K = D; t.N = D; t.ld = D; t.mode = 0; t.item = r; return true; } r -= I_OUT;
    if (r < (NE + 1) * I_GU) { const int e = r / I_GU; t.item = r % I_GU; t.src = e < NE ? p.w_exp_gate + (size_t)e * D * DE : p.w_sh_gate; t.src2 = e < NE ? p.w_exp_up + (size_t)e * D * DE : p.w_sh_up;
        t.dst = (bf16_t*)(p.ws + WS_WGUT) + (size_t)e * 512 * D; t.K = D; t.N = 512; t.ld = DE; t.mode = 2; return true; } r -= (NE + 1) * I_GU;
    { const int e = r / I_DN; t.item = r % I_DN; t.src = e < NE ? p.w_exp_down + (size_t)e * DE * D : p.w_sh_down; t.dst = (bf16_t*)(p.ws + WS_WDT) + (size_t)e * D * DE; t.K = DE; t.N = D; t.ld = D; t.mode = 0; return true; }
}
__device__ __forceinline__ void p0_prologue(const Ptrs& p, LAS unsigned char* lds, int G) {
    const int tid = threadIdx.x, lane = tid & 63, w = __builtin_amdgcn_readfirstlane(tid >> 6);
    if ((int)blockIdx.x < NMOD / 64) {
        LAS float* sil = (LAS float*)(lds + 40960);
        for (int i = tid; i < 17 * D; i += NTHREADS) { const int r = i >> 10, k = i & 1023; const float cv = (r < 16) ? p.c[r * D + k] : p.c_ctx[k]; sil[k * 20 + r] = siluf_(cv); }
        __syncthreads();
        for (int it = blockIdx.x; it < NMOD / 64; it += G) {
            LAS float* red = (LAS float*)lds;
            const int col = it * 64 + lane;
            float acc[17];
#pragma unroll
            for (int r = 0; r < 17; ++r) acc[r] = 0.f;
            for (int k0 = w * 128; k0 < w * 128 + 128; k0 += 16) {
                float wv[16];
#pragma unroll
                for (int i = 0; i < 16; ++i) wv[i] = p.w_mod[(size_t)(k0 + i) * NMOD + col];
#pragma unroll
                for (int i = 0; i < 16; ++i) { const int k = k0 + i;
                    const f32x4 s0 = *(const LAS f32x4*)(sil + k * 20), s1 = *(const LAS f32x4*)(sil + k * 20 + 4), s2 = *(const LAS f32x4*)(sil + k * 20 + 8), s3 = *(const LAS f32x4*)(sil + k * 20 + 12); const float s4 = sil[k * 20 + 16];
#pragma unroll
                    for (int j = 0; j < 4; ++j) { acc[j] += s0[j] * wv[i]; acc[4 + j] += s1[j] * wv[i]; acc[8 + j] += s2[j] * wv[i]; acc[12 + j] += s3[j] * wv[i]; }
                    acc[16] += s4 * wv[i]; }
            }
#pragma unroll
            for (int r = 0; r < 17; ++r) red[(w * 17 + r) * 64 + lane] = acc[r];
            __syncthreads();
            float* MOD = (float*)(p.ws + WS_MOD);
            for (int o = tid; o < 17 * 64; o += NTHREADS) { const int r = o >> 6, cl = o & 63; float sacc = p.b_mod[it * 64 + cl];
#pragma unroll
                for (int ww = 0; ww < 8; ++ww) sacc += red[(ww * 17 + r) * 64 + cl];
                MOD[r * NMOD + it * 64 + cl] = sacc; }
            __syncthreads();
        }
    }
    __syncthreads();
    const int gw = blockIdx.x * NWAVES + w, NGW = G * NWAVES, gt = blockIdx.x * NTHREADS + tid, NGT = G * NTHREADS;
    for (int i = gt; i < 64 * 32; i += NGT) { const int fi = i & 31, pos = i >> 5; const float ang = (float)pos * powf(10000.f, -(float)fi / 32.f); float* R = (float*)(p.ws + WS_ROPE); R[2 * i] = cosf(ang); R[2 * i + 1] = sinf(ang); }
    for (int idx = gt; idx < 2 * NBLK * 2 * 4096; idx += NGT) { const int in = idx & 63, out = (idx >> 6) & 63, gate = (idx >> 12) & 1, hb = (idx >> 13) & 7, dir = idx >> 16;
        const float* src = gate ? p.lru_w_in : p.lru_w_rec; ((bf16_t*)(p.ws + WS_WLRU))[idx] = f2bf(src[(((size_t)dir * NBLK + hb) * 64 + in) * 64 + out]); }
    for (int idx = gt; idx < NE * D; idx += NGT) { const int e = idx >> 10, k = idx & 1023; const float wv = p.w_router[(size_t)k * NE + e]; const bf16_t hi = f2bf(wv);
        ((bf16_t*)(p.ws + WS_WRT))[idx] = hi; ((bf16_t*)(p.ws + WS_WRT))[NE * D + idx] = f2bf(wv - bf2f(hi)); }
    LAS float* scr = (LAS float*)(lds + w * 8448);
    const int nmw = (G > NMOD / 64) ? NMOD / 64 : 0, nsl = ((int)blockIdx.x < nmw) ? 1 : 2;
    const int sbase = ((int)blockIdx.x < nmw) ? (int)blockIdx.x * NWAVES + w : nmw * NWAVES + (((int)blockIdx.x - nmw) * NWAVES + w) * 2, NV = nmw * NWAVES + (G - nmw) * NWAVES * 2;
    auto item_of = [&](int k) -> int { return sbase + (k % nsl) + (k / nsl) * NV; };
    TItem tc, tn; f32x4 vc[8], vn[8]; int c0 = 0, c1 = 1, n0 = 0, n1 = 1;
    bool have = p0_item_decode(p, item_of(0), tc);
    if (have) p0_item_load(tc, lane, vc, c0, c1);
    for (int k = 0; have; ++k) {
        const bool hn = p0_item_decode(p, item_of(k + 1), tn);
        if (hn) p0_item_load(tn, lane, vn, n0, n1);
        p0_item_store(tc, lane, vc, c0, c1, scr);
        tc = tn; c0 = n0; c1 = n1; have = hn;
#pragma unroll
        for (int i = 0; i < 8; ++i) vc[i] = vn[i];
    }
}
__device__ __forceinline__ void p1_norm1(const Ptrs& p, int G) {
    const int tid = threadIdx.x, lane = tid & 63, w = tid >> 6;
    for (int row0 = (blockIdx.x * NWAVES + w) * 4; row0 < NROWS; row0 += G * NWAVES * 4) {
        f32x4 v[4][4];
#pragma unroll
        for (int q = 0; q < 4; ++q) { const int row = row0 + q; const float* src = (row < NCTX) ? p.ctx + (size_t)row * D : p.x + (size_t)(row - NCTX) * D;
#pragma unroll
            for (int j = 0; j < 4; ++j) v[q][j] = *(const f32x4*)(src + j * 256 + lane * 4); }
        const int mr = (row0 < NCTX) ? 16 : (row0 - NCTX) / T;
        const float* MOD = (const float*)(p.ws + WS_MOD) + (size_t)mr * NMOD;
        f32x4 sc[4], sh[4];
#pragma unroll
        for (int j = 0; j < 4; ++j) { const int c0 = j * 256 + lane * 4; sc[j] = *(const f32x4*)(p.norm_mix + c0) * (*(const f32x4*)(MOD + D + c0) + 1.f); sh[j] = *(const f32x4*)(MOD + c0); }
#pragma unroll
        for (int q = 0; q < 4; ++q) {
            float ss = 0.f;
#pragma unroll
            for (int j = 0; j < 4; ++j) ss += v[q][j][0] * v[q][j][0] + v[q][j][1] * v[q][j][1] + v[q][j][2] * v[q][j][2] + v[q][j][3] * v[q][j][3];
            const float rstd = rsqrtf(wave_sum(ss) * (1.f / D) + EPS);
            bf16_t* dst = (bf16_t*)(p.ws + WS_XN) + (size_t)(row0 + q) * D;
#pragma unroll
            for (int j = 0; j < 4; ++j) { const f32x4 o = v[q][j] * rstd * sc[j] + sh[j];
                pg8::u32x2 pk; pk.x = pg8::cvt_pk_bf16(o[0], o[1]); pk.y = pg8::cvt_pk_bf16(o[2], o[3]); *(pg8::u32x2*)(dst + j * 256 + lane * 4) = pk; }
        }
    }
}
__device__ __forceinline__ void p6_norm2_router(const Ptrs& p, LAS unsigned char* lds, int G) {
    const int tid = threadIdx.x, lane = tid & 63, w = __builtin_amdgcn_readfirstlane(tid >> 6), fr = lane & 15, fq = lane >> 4;
    LAS float* A2 = (LAS float*)lds;
    LAS float* B2 = (LAS float*)(lds + 4096);
    LAS float* LG = (LAS float*)(lds + 8192 + w * 8448);
    LAS bf16_t* WS = (LAS bf16_t*)(lds + 75776);
    LAS int* hist = (LAS int*)(lds + 131072);
    LAS float* brl = (LAS float*)(lds + 110592);
    const bf16_t* WR = (const bf16_t*)(p.ws + WS_WRT);
    for (int vw = blockIdx.x; vw < NTOK / 256; vw += G) {
        const float* MOD = (const float*)(p.ws + WS_MOD) + (size_t)(vw * 256 / T) * NMOD;
        __syncthreads();
        if (tid < 64) { hist[tid] = 0; brl[tid] = p.b_router[tid]; }
        for (int c = tid; c < D; c += NTHREADS) { A2[c] = p.norm_ffn[c] * (1.f + MOD[4 * D + c]); B2[c] = MOD[3 * D + c]; }
        const int tok0 = vw * 256 + w * 32;
        float rstd[2];
#pragma unroll
        for (int m = 0; m < 2; ++m) { const f32x4 q4 = *(const f32x4*)((const float*)(p.ws + WS_SSQ) + (size_t)(tok0 + 16 * m + fr) * 16 + 4 * fq); float sq = (q4[0] + q4[1]) + (q4[2] + q4[3]);
            sq += __shfl_xor(sq, 16); sq += __shfl_xor(sq, 32); rstd[m] = rsqrtf(sq * (1.f / D) + EPS); }
        f32x4 acc[2][4];
#pragma unroll
        for (int m = 0; m < 2; ++m)
#pragma unroll
            for (int n = 0; n < 4; ++n) acc[m][n] = (f32x4){0.f, 0.f, 0.f, 0.f};
        struct XS { u16x8 x[2]; };
        auto load_x = [&](XS& g, int s) {
            const int c0 = 32 * s + 8 * fq;
#pragma unroll
            for (int m = 0; m < 2; ++m) { const size_t off = (size_t)(tok0 + 16 * m + fr) * D + c0; g.x[m] = *(const u16x8*)((const bf16_t*)(p.ws + WS_X1B) + off); }
        };
        auto compute_step = [&](const XS& g, int s) {
            const int c0 = 32 * s + 8 * fq, kl = (s & 3) * 32 + 8 * fq;
            pg8::bf16x8 bh[4], bl[4];
#pragma unroll
            for (int n = 0; n < 4; ++n) { bh[n] = *(const LAS pg8::bf16x8*)(WS + (16 * n + fr) * 136 + kl); bl[n] = *(const LAS pg8::bf16x8*)(WS + 64 * 136 + (16 * n + fr) * 136 + kl); }
            const f32x4 a0 = *(const LAS f32x4*)(A2 + c0), a1 = *(const LAS f32x4*)(A2 + c0 + 4), b0 = *(const LAS f32x4*)(B2 + c0), b1 = *(const LAS f32x4*)(B2 + c0 + 4);
#pragma unroll
            for (int m = 0; m < 2; ++m) {
                const size_t off = (size_t)(tok0 + 16 * m + fr) * D + c0;
                const f32x4 xa0 = {bf2f(g.x[m][0]), bf2f(g.x[m][1]), bf2f(g.x[m][2]), bf2f(g.x[m][3])}, xa1 = {bf2f(g.x[m][4]), bf2f(g.x[m][5]), bf2f(g.x[m][6]), bf2f(g.x[m][7])};
                const f32x4 h0 = xa0 * rstd[m] * a0 + b0, h1 = xa1 * rstd[m] * a1 + b1;
                pg8::u32x4 hi; hi.x = pg8::cvt_pk_bf16(h0[0], h0[1]); hi.y = pg8::cvt_pk_bf16(h0[2], h0[3]); hi.z = pg8::cvt_pk_bf16(h1[0], h1[1]); hi.w = pg8::cvt_pk_bf16(h1[2], h1[3]);
                *(pg8::u32x4*)((bf16_t*)(p.ws + WS_H2) + off) = hi;
                f32x4 r0, r1;
                r0[0] = h0[0] - __builtin_bit_cast(float, hi.x << 16); r0[1] = h0[1] - __builtin_bit_cast(float, hi.x & 0xffff0000u); r0[2] = h0[2] - __builtin_bit_cast(float, hi.y << 16); r0[3] = h0[3] - __builtin_bit_cast(float, hi.y & 0xffff0000u);
                r1[0] = h1[0] - __builtin_bit_cast(float, hi.z << 16); r1[1] = h1[1] - __builtin_bit_cast(float, hi.z & 0xffff0000u); r1[2] = h1[2] - __builtin_bit_cast(float, hi.w << 16); r1[3] = h1[3] - __builtin_bit_cast(float, hi.w & 0xffff0000u);
                pg8::u32x4 lo; lo.x = pg8::cvt_pk_bf16(r0[0], r0[1]); lo.y = pg8::cvt_pk_bf16(r0[2], r0[3]); lo.z = pg8::cvt_pk_bf16(r1[0], r1[1]); lo.w = pg8::cvt_pk_bf16(r1[2], r1[3]);
                const pg8::bf16x8 ah = __builtin_bit_cast(pg8::bf16x8, hi), al = __builtin_bit_cast(pg8::bf16x8, lo);
#pragma unroll
                for (int n = 0; n < 4; ++n) {
                    acc[m][n] = __builtin_amdgcn_mfma_f32_16x16x32_bf16(ah, bh[n], acc[m][n], 0, 0, 0);
                    acc[m][n] = __builtin_amdgcn_mfma_f32_16x16x32_bf16(ah, bl[n], acc[m][n], 0, 0, 0);
                    acc[m][n] = __builtin_amdgcn_mfma_f32_16x16x32_bf16(al, bh[n], acc[m][n], 0, 0, 0);
                }
            }
        };
        XS x0, x1, x2, x3;
        load_x(x0, 0); load_x(x1, 1); load_x(x2, 2); load_x(x3, 3);
        for (int q = 0; q < 8; ++q) {
            u16x8 wv[4];
#pragma unroll
            for (int i = 0; i < 4; ++i) { const int idx = tid + NTHREADS * i, hl = idx >> 10, e = (idx >> 4) & 63, c = idx & 15; wv[i] = *(const u16x8*)(WR + (size_t)hl * NE * D + (size_t)e * D + q * 128 + c * 8); }
            __syncthreads();
#pragma unroll
            for (int i = 0; i < 4; ++i) { const int idx = tid + NTHREADS * i, hl = idx >> 10, e = (idx >> 4) & 63, c = idx & 15; *(LAS u16x8*)(WS + hl * 64 * 136 + e * 136 + c * 8) = wv[i]; }
            __syncthreads();
            const int s = 4 * q;
            compute_step(x0, s);     if (s + 4 < 32) load_x(x0, s + 4);
            compute_step(x1, s + 1); if (s + 5 < 32) load_x(x1, s + 5);
            compute_step(x2, s + 2); if (s + 6 < 32) load_x(x2, s + 6);
            compute_step(x3, s + 3); if (s + 7 < 32) load_x(x3, s + 7);
        }
#pragma unroll
        for (int m = 0; m < 2; ++m)
#pragma unroll
            for (int n = 0; n < 4; ++n)
#pragma unroll
                for (int j = 0; j < 4; ++j) LG[(16 * m + 4 * fq + j) * 65 + 16 * n + fr] = acc[m][n][j];
        asm volatile("s_waitcnt lgkmcnt(0)" ::: "memory");
        if (lane < 32) {
            const int tok = tok0 + lane;
            float sv[64];
            float gs[8];
#pragma unroll
            for (int g = 0; g < 8; ++g) {
                float m1 = -INFINITY, m2 = -INFINITY;
#pragma unroll
                for (int i = 0; i < 8; ++i) { const int e = 8 * g + i; const float sg = __builtin_amdgcn_rcpf(1.f + __builtin_amdgcn_exp2f(-1.4426950408889634f * LG[lane * 65 + e])); sv[e] = sg;
                    const float sb = sg + brl[e]; if (sb > m1) { m2 = m1; m1 = sb; } else if (sb > m2) m2 = sb; }
                gs[g] = m1 + m2;
            }
            unsigned gsel = 0;
#pragma unroll
            for (int g = 0; g < 8; ++g) { int rk = 0;
#pragma unroll
                for (int g2 = 0; g2 < 8; ++g2) rk += (gs[g2] > gs[g] || (gs[g2] == gs[g] && g2 < g)) ? 1 : 0;
                if (rk < 4) gsel |= 1u << g; }
            float tv[TOPK]; int ti[TOPK];
#pragma unroll
            for (int k = 0; k < TOPK; ++k) { tv[k] = -INFINITY; ti[k] = 0; }
#pragma unroll
            for (int e = 0; e < 64; ++e) {
                float cx = ((gsel >> (e >> 3)) & 1u) ? sv[e] + brl[e] : -INFINITY; int ci = e;
#pragma unroll
                for (int k = 0; k < TOPK; ++k) { const bool gt = cx > tv[k]; const float ov = tv[k]; const int oi = ti[k]; tv[k] = gt ? cx : ov; ti[k] = gt ? ci : oi; cx = gt ? ov : cx; ci = gt ? oi : ci; }
            }
            float ssum = 0.f, sk[TOPK];
#pragma unroll
            for (int k = 0; k < TOPK; ++k) { sk[k] = tv[k] - brl[ti[k]]; ssum += sk[k]; }
            const float inv = 2.5f / ssum;
#pragma unroll
            for (int k = 0; k < TOPK; ++k) { const int pos = __hip_atomic_fetch_add(&hist[ti[k]], 1, __ATOMIC_RELAXED, __HIP_MEMORY_SCOPE_WORKGROUP);
                ((int*)(p.ws + WS_EIDX))[(size_t)tok * TOPK + k] = ti[k] | (pos << 8); ((float*)(p.ws + WS_GATE))[(size_t)tok * TOPK + k] = sk[k] * inv; }
        }
        __syncthreads();
        if (tid < 64) ((int*)(p.ws + WS_HIST))[vw * 64 + tid] = hist[tid];
    }
}

__global__ void __launch_bounds__(NTHREADS, 2) mega(Args args) {
    extern __shared__ __attribute__((aligned(16))) unsigned char lds_raw[];
    LAS unsigned char* lds = (LAS unsigned char*)lds_raw;
    const Ptrs& p = args.p;
    const int tid = threadIdx.x, G = gridDim.x;
    volatile LAS unsigned* MISC = (volatile LAS unsigned*)(lds + MISC_OFF);
    for (int u = tid; u < (LDS_BYTES - RING_BYTES) / 4; u += NTHREADS) ((LAS unsigned*)(lds + RING_BYTES))[u] = 0u;
    __syncthreads();
    unsigned* ctl = (unsigned*)(p.ws + WS_CTL);
    XcdBarrier bar = xcd_barrier_post(ctl + CW_BAR, MISC + 8);
    const int lo = args.ph_lo, hi = args.ph_hi;
#define IN(k) (lo <= (k) && (k) < hi)
#define SEAM(k) do { if (IN(k) && IN((k) + 1)) xcd_barrier(bar); } while (0)
    if (IN(0)) p0_prologue(p, lds, G);
    SEAM(0);
    if (IN(1)) p1_norm1(p, G);
    SEAM(1);
    if (IN(2)) {
        pg8::DenseOrder S; S.init(p.ws + WS_XN, p.ws + WS_WINT, NROWS, NPROJ, D, G, (int)blockIdx.x);
        EpiInProj E{(bf16_t*)(p.ws + WS_PROJ), (const float*)(p.ws + WS_ROPE)};
        pg8::gemm_phase<EpiInProj, pg8::DenseOrder, false>(lds, D, S, E, nullptr);
    }
    SEAM(2);
    const int upair = ((G & 15) == 0) ? (((int)blockIdx.x >> 4) * 16 + ((int)blockIdx.x & 7) * 2 + (((int)blockIdx.x >> 3) & 1)) : (int)blockIdx.x;
    if (IN(3)) { for (int u = upair; u < NB * NBLK * 2; u += G) lru_unit(p, lds, u); }
    if (IN(3)) { for (int u = upair; u < NB * NH * 4; u += G) ret_state_walk(p, lds, u); }
    SEAM(3);
    if (IN(4)) { for (int j = blockIdx.x; j < NB * NH * 32; j += G) { const int nn = j >> 6, n = (nn & 1) ? 31 - (nn >> 1) : (nn >> 1); ret_chunk_out(p, lds, (j & 63) * 32 + n); } }
    SEAM(4);
    if (IN(5)) {
        pg8::DenseOrder S; S.init(p.ws + WS_Y, p.ws + WS_WOUTT, NTOK, D, D, G, (int)blockIdx.x);
        EpiOutProj E{p.x, (const float*)(p.ws + WS_MOD), (bf16_t*)(p.ws + WS_X1B), (float*)(p.ws + WS_SSQ)};
        pg8::gemm_phase<EpiOutProj, pg8::DenseOrder, false>(lds, D, S, E, nullptr);
    }
    SEAM(5);
    if (IN(6)) p6_norm2_router(p, lds, G);
    SEAM(6);
    if (IN(7)) {
        LAS int* sm = (LAS int*)lds;
        const int* HIST = (const int*)(p.ws + WS_HIST); const int* EI = (const int*)(p.ws + WS_EIDX);
        int* TOKL = (int*)(p.ws + WS_LIST); int* SLOT = (int*)(p.ws + WS_LIST) + LIST_N;
        int* TILE = (int*)(p.ws + WS_TILE);
        for (int vw = blockIdx.x; vw < NTOK / 256; vw += G) {
            const int q = vw >> 7, wl = vw & 127, e = tid & 63, g = tid >> 6;
            int tot = 0, bef = 0;
            for (int w = 16 * g; w < 16 * g + 16; ++w) { const int v = HIST[(q * 128 + w) * 64 + e]; tot += v; if (w < wl) bef += v; }
            sm[g * 64 + e] = tot; sm[512 + g * 64 + e] = bef;
            __syncthreads();
            if (tid < 64) {
                int total = 0, before = 0;
#pragma unroll
                for (int gg = 0; gg < 8; ++gg) { total += sm[gg * 64 + tid]; before += sm[512 + gg * 64 + tid]; }
                const int padded = (total + 255) & ~255; int incl = padded;
#pragma unroll
                for (int o = 1; o < 64; o <<= 1) { const int t = __shfl_up(incl, o); if (tid >= o) incl += t; }
                const int pstart = incl - padded;
                sm[1024 + tid] = total; sm[1088 + tid] = pstart; sm[1152 + tid] = pstart + before; if (tid == 63) sm[1216] = incl >> 8;
            }
            __syncthreads();
            const size_t lb = (size_t)q * SLOTS_PART;
            for (int a = tid; a < 256 * TOPK; a += NTHREADS) {
                const int tl = a / TOPK, k = a - tl * TOPK, tok = vw * 256 + tl, pk = EI[(size_t)tok * TOPK + k], ee = pk & 255, pos = pk >> 8;
                const size_t slot = lb + sm[1152 + ee] + pos;
                TOKL[slot] = tok; SLOT[(size_t)tok * TOPK + k] = (int)slot;
            }
            if (tid < 256) { const size_t slot = lb + (size_t)RT_ROUTED * 256 + wl * 256 + tid; TOKL[slot] = vw * 256 + tid; }
            if (wl < 64) { const int cnt = sm[1024 + wl], st = sm[1088 + wl], pe = (cnt + 255) & ~255;
                for (int i = cnt + tid; i < pe; i += NTHREADS) { const size_t slot = lb + st + i; TOKL[slot] = q * PTOK; } }
            if (wl == 64) { const int nrt = sm[1216];
                for (int rt = tid; rt < nrt; rt += NTHREADS) { int ee = 0; for (int x = 1; x < 64; ++x) if (sm[1088 + x] <= rt * 256) ee = x; TILE[64 + q * RT_PART + rt] = ee; }
                if (tid == 0) TILE[q] = nrt; }
            __syncthreads();
        }
    }
    SEAM(7);
#ifndef NO_P8
    if (IN(8)) {
        const int* TILE = (const int*)(p.ws + WS_TILE);
        MoeOrderGU S{(const char*)(p.ws + WS_H2), (const char*)(p.ws + WS_WGUT), TILE + 64, TILE[0], TILE[1], G, (int)blockIdx.x};
        EpiGateUp E{(bf16_t*)(p.ws + WS_HB)};
        pg8::gemm_phase<EpiGateUp, MoeOrderGU, true>(lds, D, S, E, (const int*)(p.ws + WS_LIST));
    }
#endif
    SEAM(8);
    if (IN(9)) {
        const int* TILE = (const int*)(p.ws + WS_TILE);
        MoeOrderDown S{(const char*)(p.ws + WS_HB), (const char*)(p.ws + WS_WDT), TILE + 64, TILE[0], TILE[1], G, (int)blockIdx.x};
        EpiDown E{(unsigned char*)(p.ws + WS_YT)};
        int Kd = DE; asm volatile("" : "+s"(Kd));
        pg8::gemm_phase<EpiDown, MoeOrderDown, false>(lds, Kd, S, E, nullptr);
    }
    SEAM(9);
    if (IN(10)) {
        const int lane = tid & 63, wv = tid >> 6;
        const unsigned char* YT = (const unsigned char*)(p.ws + WS_YT);
        typedef float f32x2 __attribute__((ext_vector_type(2)));
        for (int tok0 = (blockIdx.x * NWAVES + wv) * 2; tok0 < NTOK; tok0 += G * NWAVES * 2) {
            const float* MODb = (const float*)(p.ws + WS_MOD) + (size_t)(tok0 / T) * NMOD + 5 * D + lane * 16;
            pg8::u32x4 yv[2][7]; u16x8 xa[2], xb[2]; float gk[2][7];
            const int* SLOT = (const int*)(p.ws + WS_LIST) + LIST_N; const float* GT = (const float*)(p.ws + WS_GATE);
#pragma unroll
            for (int q = 0; q < 2; ++q) {
                const int tok = tok0 + q, part = tok / PTOK;
#pragma unroll
                for (int k = 0; k < 7; ++k) { const size_t slot = (k < TOPK) ? (size_t)SLOT[(size_t)tok * TOPK + k] : (size_t)part * SLOTS_PART + (size_t)RT_ROUTED * 256 + (tok - part * PTOK);
                    gk[q][k] = (k < TOPK) ? GT[(size_t)tok * TOPK + k] : 1.f;
                    yv[q][k] = *(const pg8::u32x4*)(YT + slot * D + lane * 16); }
                const bf16_t* x1r = (const bf16_t*)(p.ws + WS_X1B) + (size_t)tok * D + lane * 16; xa[q] = *(const u16x8*)x1r; xb[q] = *(const u16x8*)(x1r + 8);
            }
            f32x4 g2[4], nf[4];
#pragma unroll
            for (int i = 0; i < 4; ++i) { g2[i] = *(const f32x4*)(MODb + 4 * i) * 0.0625f; nf[i] = *(const f32x4*)(p.norm_final + lane * 16 + 4 * i); }
#pragma unroll
            for (int q = 0; q < 2; ++q) {
                float a[16];
#pragma unroll
                for (int j = 0; j < 16; ++j) a[j] = 0.f;
#pragma unroll
                for (int k = 0; k < 7; ++k)
#pragma unroll
                    for (int i = 0; i < 4; ++i) { const int wd = (int)yv[q][k][i]; const f32x2 lo = __builtin_amdgcn_cvt_pk_f32_fp8(wd, false), hi = __builtin_amdgcn_cvt_pk_f32_fp8(wd, true);
                        a[4 * i] += gk[q][k] * lo[0]; a[4 * i + 1] += gk[q][k] * lo[1]; a[4 * i + 2] += gk[q][k] * hi[0]; a[4 * i + 3] += gk[q][k] * hi[1]; }
                f32x4 xv[4];
#pragma unroll
                for (int j = 0; j < 4; ++j) { xv[0][j] = bf2f(xa[q][j]); xv[1][j] = bf2f(xa[q][4 + j]); xv[2][j] = bf2f(xb[q][j]); xv[3][j] = bf2f(xb[q][4 + j]); }
                f32x4 v[4]; float ss = 0.f;
#pragma unroll
                for (int i = 0; i < 4; ++i) { const f32x4 av = {a[4 * i], a[4 * i + 1], a[4 * i + 2], a[4 * i + 3]};
                    v[i] = xv[i] + g2[i] * av; ss += v[i][0] * v[i][0] + v[i][1] * v[i][1] + v[i][2] * v[i][2] + v[i][3] * v[i][3]; }
                const float rstd = rsqrtf(wave_sum(ss) * (1.f / D) + EPS);
                float* xr = p.out + (size_t)(tok0 + q) * D + lane * 16;
#pragma unroll
                for (int i = 0; i < 4; ++i) *(f32x4*)(xr + 4 * i) = v[i] * rstd * nf[i];
            }
        }
    }
    SEAM(10);
#undef IN
#undef SEAM
}

static void launch_mega(const Ptrs& p, int lo, int hi, hipStream_t stream) {
    static int grid = 0;
    if (grid == 0) {
        int dev = 0, cus = 0, per_cu = 0;
        (void)hipGetDevice(&dev); (void)hipDeviceGetAttribute(&cus, hipDeviceAttributeMultiprocessorCount, dev);
        if (hipFuncSetAttribute((const void*)mega, hipFuncAttributeMaxDynamicSharedMemorySize, LDS_BYTES) != hipSuccess) { fprintf(stderr, "hipFuncSetAttribute failed\n"); grid = -1; return; }
        if (hipOccupancyMaxActiveBlocksPerMultiprocessor(&per_cu, (const void*)mega, NTHREADS, LDS_BYTES) != hipSuccess || per_cu < 1) fprintf(stderr, "occupancy query reports %d blocks per CU\n", per_cu);
        (void)hipGetLastError();
        grid = cus > 0 ? cus : 256;
    }
    if (grid < 0) return;
    Args a{}; a.p = p; a.ph_lo = lo; a.ph_hi = hi;
    hipLaunchKernelGGL(mega, dim3(grid), dim3(NTHREADS), LDS_BYTES, stream, a);
}

extern "C" void kernel_launch(void* const* d_in, const int* in_sizes, int n_in, void* d_out, int out_size, void* d_ws, size_t ws_size, hipStream_t stream) {
    if (n_in != 26 || out_size != NTOK * D || ws_size < WS_END) { fprintf(stderr, "kernel_launch: unexpected problem (n_in %d out %d ws %zu)\n", n_in, out_size, ws_size); return; }
    Ptrs p{};
    const float** f = (const float**)&p;
    for (int i = 0; i < 26; ++i) f[i] = (const float*)d_in[i];
    p.out = (float*)d_out; p.ws = (unsigned char*)d_ws;
    (void)hipMemsetAsync(p.ws + WS_CTL, 0, CTL_ZERO_BYTES, stream);
    launch_mega(p, 0, 11, stream);
}
```

```cpp
#include <hip/hip_runtime.h>
#include <cstdio>
#include <cstdint>

typedef unsigned short bf16_t;
typedef float f32x4 __attribute__((ext_vector_type(4)));
typedef unsigned short u16x4 __attribute__((ext_vector_type(4)));
typedef unsigned short u16x8 __attribute__((ext_vector_type(8)));

constexpr int NB = 16, T = 4096, D = 1024, LC = 256;
constexpr int NTOK = NB * T;
constexpr int NCTX = NB * LC;
constexpr int NROWS = NCTX + NTOK;
constexpr int NPROJ = 3072;
constexpr int C_XA = 0, C_GA = 512, C_Q = 1024, C_K = 1536, C_V = 2048, C_G = 2560;
constexpr int DL = 512, NBLK = 8, BD = 64;
constexpr int NH = 4, HD = 128;
constexpr int NE = 64, TOPK = 6, DE = 256;
constexpr int NMOD = 6 * D;
__host__ __device__ __forceinline__ size_t proj_blk(int g, int blk) { return g < 2 ? ((size_t)(g * 8 + blk) * NROWS) * 64 : (size_t)2 * NROWS * 512 + ((size_t)((g - 2) * 4 + blk) * NROWS) * 128; }
constexpr float EPS = 1e-6f;

constexpr size_t MiB = 1u << 20;
constexpr size_t WS_CTL = 0, WS_MOD = 1 * MiB, WS_ROPE = 2 * MiB, WS_EIDX = 3 * MiB, WS_GATE = 5 * MiB, WS_SCTX = 7 * MiB;
constexpr size_t WS_WINT = 16 * MiB, WS_WOUTT = 23 * MiB, WS_WGUT = 25 * MiB, WS_WDT = 90 * MiB;
constexpr size_t WS_XN = 128 * MiB, WS_PROJ = 264 * MiB, WS_Y = 672 * MiB, WS_HF = 800 * MiB;
constexpr size_t WS_H2 = 368 * MiB;
constexpr size_t WS_X1B = 848 * MiB;
constexpr int NPART = 1, PTOK = NTOK / NPART, GPP = PTOK / 256, RT_ROUTED = PTOK * 6 / 256 + 64, RT_PART = RT_ROUTED + GPP, SLOTS_PART = RT_PART * 256;
constexpr size_t WS_HIST = 512 * 1024, WS_TILE = 123 * MiB;
constexpr size_t WS_HB = 128 * MiB, WS_YT = 368 * MiB, WS_LIST = 976 * MiB, WS_END = 992 * MiB;
constexpr size_t LIST_N = (size_t)NPART * SLOTS_PART;

struct Ptrs {
    const float *x, *c, *ctx, *c_ctx, *w_mod, *b_mod, *norm_mix, *norm_ffn, *w_in, *conv_w, *conv_b, *lru_w_rec, *lru_b_rec, *lru_w_in, *lru_b_in,
        *lru_lambda, *w_out, *w_router, *b_router, *w_exp_gate, *w_exp_up, *w_exp_down, *w_sh_gate, *w_sh_up, *w_sh_down, *norm_final;
    float* out; unsigned char* ws;
};

__host__ __device__ __forceinline__ bf16_t f2bf(float f) { unsigned u = __builtin_bit_cast(unsigned, f); return (bf16_t)((u + 0x7fffu + ((u >> 16) & 1u)) >> 16); }
__host__ __device__ __forceinline__ float bf2f(bf16_t h) { return __builtin_bit_cast(float, (unsigned)h << 16); }
__device__ __forceinline__ float sigmoidf_(float v) { return 1.f / (1.f + __expf(-v)); }
__device__ __forceinline__ float siluf_(float v) { return v / (1.f + __expf(-v)); }
__device__ __forceinline__ float gelu_tanh(float v) { const float u = 0.7978845608028654f * (v + 0.044715f * v * v * v); return 0.5f * v * (1.f + tanhf(u)); }
__device__ __forceinline__ float wave_sum(float v) {
#pragma unroll
    for (int o = 1; o < 64; o <<= 1) v += __shfl_xor(v, o);
    return v;
}
__device__ __forceinline__ float ret_logg(int h) { return log1pf(-exp2f(-(5.f + 2.f * (float)h))); }
__host__ __device__ __forceinline__ int rope_src_col(int n) { const int hh = n >> 7, p = n & 127, ip = p >> 1, s = p & 1; const int d = (ip < 32) ? (ip + 32 * s) : (64 + (ip - 32) + 32 * s); return hh * 128 + d; }

__device__ __forceinline__ int tid_fresh() { int t = (int)threadIdx.x; asm volatile("" : "+v"(t)); return t & 511; }
#define LAS __attribute__((address_space(3)))
namespace pg8 {
typedef short bf16x8 __attribute__((ext_vector_type(8)));
typedef unsigned u32x4 __attribute__((ext_vector_type(4)));
typedef unsigned u32x2 __attribute__((ext_vector_type(2)));
constexpr int BM = 256, BK = 64, HALF = 128, HTB = HALF * BK * 2, STAGE_BYTES = 8 * HTB, NXCD = 8, WGM = 8;
__host__ __device__ __forceinline__ int lds_byte(int r, int c) { const int st = (r >> 4) * 2 + (c >> 5), rr = r & 15, cc = c & 31, ob = rr * 64 + cc * 2; return st * 1024 + (ob ^ (((ob >> 9) & 1) << 5)); }
__host__ __device__ __forceinline__ void stage_rc(int b, int& R, int& C) { const int st = b / 1024, sb = b % 1024, swz = sb ^ (((sb >> 9) & 1) << 5); R = (st >> 1) * 16 + swz / 64; C = (st & 1) * 32 + (swz % 64) / 2; }
__host__ __device__ __forceinline__ int perm32(int rho) { const int n = rho >> 4, i = rho & 15; return 8 * (i >> 2) + 4 * n + (i & 3); }
__device__ __forceinline__ unsigned cvt_pk_bf16(float lo, float hi) { unsigned r; asm volatile("v_cvt_pk_bf16_f32 %0, %1, %2" : "=v"(r) : "v"(lo), "v"(hi)); return r; }

struct Unit { const char* A; const char* B; int pm, pn, aux, pad; };

struct DenseOrder {
    const char* A; const char* B; int nM, nN, nwg, G, c, K;
    __device__ void init(const void* A_, const void* B_, int M, int N, int K_, int G_, int c_) { A = (const char*)A_; B = (const char*)B_; nM = M / BM; nN = N / BM; nwg = nM * nN; G = G_; c = c_; K = K_; }
    __device__ bool next(int i, Unit& u) const {
        const long L = (long)i * G + c; if (L >= nwg) return false;
        int wgid = (int)L; { const int q = nwg / NXCD, r = nwg % NXCD, xcd = wgid % NXCD, off = wgid / NXCD; wgid = (xcd < r ? xcd * (q + 1) : r * (q + 1) + (xcd - r) * q) + off; }
        const int nig = WGM * nN, gid = wgid / nig, fm = gid * WGM, gsz = (nM - fm) < WGM ? (nM - fm) : WGM;
        u.pm = fm + ((wgid % nig) % gsz); u.pn = (wgid % nig) / gsz; u.aux = 0; u.pad = 0;
        u.A = A + (size_t)u.pm * BM * K * 2; u.B = B + (size_t)u.pn * BM * K * 2; return true;
    }
};

template <class Epi, class Sched, bool GATHER>
__device__ __forceinline__ void gemm_phase(LAS unsigned char* lds, const int K, const Sched& S, const Epi& E, const LAS int* rowlist) {
    const int tid = tid_fresh(), wid = __builtin_amdgcn_readfirstlane(tid >> 6), lane = tid & 63, wr = wid >> 2, wc = wid & 3, fr = lane & 15, fq = lane >> 4;
    const int nt = K / BK;
    unsigned voffA[2], voffB[2];
#pragma unroll
    for (int i = 0; i < 2; ++i) { int R, C; stage_rc(tid * 16 + i * 8192, R, C);
        const int cb = Epi::BQUAD ? 256 * ((R >> 4) & 1) + 16 * (R >> 5) + 4 * ((R & 15) >> 2) + (R & 3) : 64 * (R >> 5) + 16 * ((R & 15) >> 2) + 4 * ((R >> 4) & 1) + (R & 3);
        voffA[i] = (unsigned)(R * K + C) * 2u; voffB[i] = (unsigned)((Epi::SWAP ? Epi::wrow(R) : cb) * K + C) * 2u; }
    const size_t wstep = (size_t)(Epi::SWAP ? Epi::WHALF : (Epi::BQUAD ? 512 : 8)) * K * 2;
    const size_t kstep = (size_t)(BK * 2);
    const size_t hstep = (size_t)HALF * K * 2;
    const unsigned ldsw = (unsigned)wid * 1024u;
    const int aoff = lds_byte(wr * 64 + fr, fq * 8), boff = lds_byte(wc * 32 + fr, fq * 8);
#define PG8_SA(b, h) (((b) * 2 + (h)) * HTB)
#define PG8_SB(b, h) ((4 + (b) * 2 + (h)) * HTB)
#define PG8_STAGE(bufoff, gbase, voff) do { _Pragma("unroll") for (int _i = 0; _i < 2; ++_i) \
        __builtin_amdgcn_global_load_lds((const unsigned*)((const char*)(gbase) + (voff)[_i]), (LAS unsigned*)(lds + (bufoff) + ldsw + _i * 8192), 16, 0, 0); } while (0)
#define PG8_STAGE_A(bufoff, gbase, h, NX) do { if constexpr (GATHER) { if (NX) { if (h) PG8_STAGE(bufoff, gbase, gvN1); else PG8_STAGE(bufoff, gbase, gvN0); } else { if (h) PG8_STAGE(bufoff, gbase, gvC1); else PG8_STAGE(bufoff, gbase, gvC0); } } \
        else PG8_STAGE(bufoff, (gbase) + (h) * hstep, voffA); } while (0)
#define PG8_STAGE_W(bufoff, gbase, h) PG8_STAGE(bufoff, (gbase) + (h) * wstep, voffB)
#define PG8_SIDE_A(bufoff, ta, tb, h, NX) do { if constexpr (Epi::SWAP) PG8_STAGE_W(bufoff, tb, h); else PG8_STAGE_A(bufoff, ta, h, NX); } while (0)
#define PG8_SIDE_B(bufoff, ta, tb, h, NX) do { if constexpr (Epi::SWAP) PG8_STAGE_A(bufoff, ta, h, NX); else PG8_STAGE_W(bufoff, tb, h); } while (0)
#define PG8_LDA(dst, b, h) do { _Pragma("unroll") for (int m = 0; m < 4; ++m) _Pragma("unroll") for (int k = 0; k < 2; ++k) dst[m][k] = *(const LAS bf16x8*)(lds + PG8_SA(b, h) + aoff + m * 2048 + k * 1024); } while (0)
#define PG8_LDB(dst, b, h) do { _Pragma("unroll") for (int n = 0; n < 2; ++n) _Pragma("unroll") for (int k = 0; k < 2; ++k) dst[n][k] = *(const LAS bf16x8*)(lds + PG8_SB(b, h) + boff + n * 2048 + k * 1024); } while (0)
#define PG8_MMA(ai, bj, At, Bt) do { __builtin_amdgcn_s_setprio(1); _Pragma("unroll") for (int m = 0; m < 4; ++m) _Pragma("unroll") for (int n = 0; n < 2; ++n) _Pragma("unroll") for (int k = 0; k < 2; ++k) \
        acc[ai][bj][m][n] = __builtin_amdgcn_mfma_f32_16x16x32_bf16(Bt[n][k], At[m][k], acc[ai][bj][m][n], 0, 0, 0); __builtin_amdgcn_s_setprio(0); } while (0)
#define PG8_MMAZ(ai, bj, At, Bt) do { __builtin_amdgcn_s_setprio(1); _Pragma("unroll") for (int m = 0; m < 4; ++m) _Pragma("unroll") for (int n = 0; n < 2; ++n) { \
        acc[ai][bj][m][n] = __builtin_amdgcn_mfma_f32_16x16x32_bf16(Bt[n][0], At[m][0], (f32x4){0.f, 0.f, 0.f, 0.f}, 0, 0, 0); \
        acc[ai][bj][m][n] = __builtin_amdgcn_mfma_f32_16x16x32_bf16(Bt[n][1], At[m][1], acc[ai][bj][m][n], 0, 0, 0); } __builtin_amdgcn_s_setprio(0); } while (0)
#define PG8_WAIT_V(n) asm volatile("s_waitcnt vmcnt(" #n ")" ::: "memory")
#define PG8_WAIT_L(n) asm volatile("s_waitcnt lgkmcnt(" #n ")" ::: "memory")
#define PG8_BAR __builtin_amdgcn_s_barrier()
#define PG8_SCHED __builtin_amdgcn_sched_barrier(0)
    Unit cur, nxt; int ui = 0;
    if (!S.next(0, cur)) return;
    unsigned gvC0[2] = {0u, 0u}, gvC1[2] = {0u, 0u}, gvN0[2] = {0u, 0u}, gvN1[2] = {0u, 0u};
    if constexpr (GATHER) {
#pragma unroll
        for (int i = 0; i < 2; ++i) { const LAS int* rl = rowlist;
            int R, C; { int tt = tid; asm volatile("" : "+v"(tt)); stage_rc(tt * 16 + i * 8192, R, C); }
            gvC0[i] = ((unsigned)rl[R] * (unsigned)K + (unsigned)C) * 2u; gvC1[i] = ((unsigned)rl[HALF + R] * (unsigned)K + (unsigned)C) * 2u; }
    }
    f32x4 acc[2][2][4][2];
    bf16x8 At[4][2], B0[2][2], B1[2][2];
    const char* cA = cur.A; const char* cB = cur.B;
    PG8_SIDE_B(PG8_SB(0, 0), cA, cB, 0, false); PG8_SIDE_B(PG8_SB(0, 1), cA, cB, 1, false); PG8_SIDE_A(PG8_SA(0, 0), cA, cB, 0, false); PG8_SIDE_A(PG8_SA(0, 1), cA, cB, 1, false);
    if (wr == 1) PG8_BAR;
    PG8_WAIT_V(2); PG8_BAR;
    PG8_SIDE_B(PG8_SB(1, 0), cA + kstep, cB + kstep, 0, false); PG8_SIDE_A(PG8_SA(1, 0), cA + kstep, cB + kstep, 0, false); PG8_SIDE_B(PG8_SB(1, 1), cA + kstep, cB + kstep, 1, false);
    PG8_WAIT_V(6); PG8_BAR;
    for (;;) {
        const bool has_next = S.next(ui + 1, nxt);
        const char* nA = has_next ? nxt.A : cA; const char* nB = has_next ? nxt.B : cB;
        if constexpr (GATHER) {
            if (has_next) {
#pragma unroll
                for (int i = 0; i < 2; ++i) { const LAS int* rl = rowlist + (ui + 1) * BM;
                    int R, C; { int tt = tid; asm volatile("" : "+v"(tt)); stage_rc(tt * 16 + i * 8192, R, C); }
                    gvN0[i] = ((unsigned)rl[R] * (unsigned)K + (unsigned)C) * 2u; gvN1[i] = ((unsigned)rl[HALF + R] * (unsigned)K + (unsigned)C) * 2u; }
            } else { gvN0[0] = gvC0[0]; gvN0[1] = gvC0[1]; gvN1[0] = gvC1[0]; gvN1[1] = gvC1[1]; }
        }
#define PG8_KPAIR(t, MMA0) do { \
            const bool last = ((t) == nt - 2); \
            const char* a1 = cA + (size_t)((t) + 1) * kstep; const char* b1 = cB + (size_t)((t) + 1) * kstep; \
            const char* a2 = last ? nA : cA + (size_t)((t) + 2) * kstep; const char* b2 = last ? nB : cB + (size_t)((t) + 2) * kstep; \
            const char* a3 = a2 + kstep; const char* b3 = b2 + kstep; \
            asm volatile("" : "+s"(a1), "+s"(b1), "+s"(a2), "+s"(b2), "+s"(a3), "+s"(b3));        \
            PG8_LDB(B0, 0, 0); PG8_LDB(B1, 0, 1); PG8_SCHED; PG8_LDA(At, 0, 0); PG8_SIDE_A(PG8_SA(1, 1), a1, b1, 1, false); \
            PG8_WAIT_V(8); PG8_WAIT_L(0); PG8_BAR; MMA0(0, 0, At, B0); MMA0(0, 1, At, B1); PG8_BAR; PG8_SCHED; \
            PG8_LDA(At, 0, 1); PG8_SIDE_B(PG8_SB(0, 0), a2, b2, 0, last); PG8_SIDE_B(PG8_SB(0, 1), a2, b2, 1, last); PG8_SIDE_A(PG8_SA(0, 0), a2, b2, 0, last); \
            PG8_WAIT_V(8); PG8_WAIT_L(0); PG8_BAR; MMA0(1, 0, At, B0); MMA0(1, 1, At, B1); PG8_BAR; PG8_SCHED; \
            PG8_LDB(B0, 1, 0); PG8_LDB(B1, 1, 1); PG8_SCHED; PG8_LDA(At, 1, 0); PG8_SIDE_A(PG8_SA(0, 1), a2, b2, 1, last); \
            PG8_WAIT_V(8); PG8_WAIT_L(0); PG8_BAR; PG8_MMA(0, 0, At, B0); PG8_MMA(0, 1, At, B1); PG8_BAR; PG8_SCHED; \
            PG8_LDA(At, 1, 1); PG8_SIDE_B(PG8_SB(1, 0), a3, b3, 0, last); PG8_SIDE_B(PG8_SB(1, 1), a3, b3, 1, last); PG8_SIDE_A(PG8_SA(1, 0), a3, b3, 0, last); \
            PG8_WAIT_V(8); PG8_WAIT_L(0); PG8_BAR; PG8_MMA(1, 0, At, B0); PG8_MMA(1, 1, At, B1); PG8_BAR; PG8_SCHED; } while (0)
        PG8_KPAIR(0, PG8_MMAZ);
        for (int t = 2; t < nt; t += 2) PG8_KPAIR(t, PG8_MMA);
#undef PG8_KPAIR
        if (wr == 0) PG8_BAR;
        E(acc, cur, wr, wc, fr, fq);
        if (!has_next) break;
        cur = nxt; cA = nA; cB = nB; ++ui;
        if constexpr (GATHER) { gvC0[0] = gvN0[0]; gvC0[1] = gvN0[1]; gvC1[0] = gvN1[0]; gvC1[1] = gvN1[1]; }
        if (wr == 1) PG8_BAR;
    }
    PG8_WAIT_V(0);
    PG8_BAR;
#undef PG8_SA
#undef PG8_SB
#undef PG8_STAGE
#undef PG8_STAGE_A
#undef PG8_STAGE_W
#undef PG8_SIDE_A
#undef PG8_SIDE_B
#undef PG8_LDA
#undef PG8_LDB
#undef PG8_MMA
#undef PG8_MMAZ
#undef PG8_WAIT_V
#undef PG8_WAIT_L
#undef PG8_BAR
#undef PG8_SCHED
}
}
typedef __attribute__((address_space(1))) unsigned gu32;
#define RLX_AGENT __ATOMIC_RELAXED, __HIP_MEMORY_SCOPE_AGENT
#define XB_TMO      128
#define XB_XCNT(j)  (256  + 64 * (j))
#define XB_XSUB(j)  (1280 + 64 * (j))
#define XB_XGEN(j)  (2304 + 64 * (j))
#define XB_TOP      3328
#define XB_TOPGEN   3392
#define XCD_BAR_WORDS 3456
#define XB_SPIN_CAP (1u << 18)
__device__ __forceinline__ unsigned xb_ld(unsigned* p)              { return __hip_atomic_load(p, __ATOMIC_RELAXED, __HIP_MEMORY_SCOPE_AGENT); }
__device__ __forceinline__ unsigned xb_add(unsigned* p, unsigned v) { return __hip_atomic_fetch_add(p, v, __ATOMIC_RELAXED, __HIP_MEMORY_SCOPE_AGENT); }
__device__ __forceinline__ unsigned xb_xcc_id() { return (unsigned)__builtin_amdgcn_s_getreg((3 << 11) | 20) & 0xFu; }
#define XB_SPIN(cond, bar) do { unsigned _sp = 0; while (cond) { __builtin_amdgcn_s_sleep(1); \
    if ((++_sp & 255u) == 0u) { if (xb_ld(&(bar)[XB_TMO])) break; if (_sp > XB_SPIN_CAP) { atomicAdd(&(bar)[XB_TMO], 1u); break; } } } } while (0)
struct XcdBarrier { unsigned* bar; unsigned x; volatile LAS unsigned* st; };
__device__ __forceinline__ XcdBarrier xcd_barrier_post(unsigned* bar, volatile LAS unsigned* st) {
    XcdBarrier b; b.bar = bar; b.x = xb_xcc_id(); b.st = st;
    if (threadIdx.x == 0) (void)xb_add(&bar[XB_XCNT(b.x)], 1u);
    return b;
}
__device__ __forceinline__ void xcd_barrier_complete(unsigned* bar, unsigned x, unsigned& nloc, unsigned& nx) {
    const unsigned G = gridDim.x * gridDim.y * gridDim.z;
    unsigned sum, cnt, mine, sp = 0u;
    for (;;) {
        sum = 0u; cnt = 0u; mine = 0u;
#pragma unroll
        for (unsigned j = 0; j < 16; ++j) { const unsigned c = xb_ld(&bar[XB_XCNT(j)]); sum += c; cnt += (c > 0u) ? 1u : 0u; mine = (j == x) ? c : mine; }
        if (sum == G) break;
        __builtin_amdgcn_s_sleep(1);
        if ((++sp & 255u) == 0u) { if (xb_ld(&bar[XB_TMO])) break; if (sp > XB_SPIN_CAP) { atomicAdd(&bar[XB_TMO], 1u); break; } }
    }
    nloc = mine > 0u ? mine : 1u; nx = cnt > 0u ? cnt : 1u;
}
__device__ __forceinline__ void xcd_barrier(const XcdBarrier& b) {
    asm volatile("s_waitcnt vmcnt(0)" ::: "memory");
    __syncthreads();
    if (threadIdx.x == 0) {
        unsigned* bar = b.bar;
        __builtin_amdgcn_s_waitcnt(0);
        unsigned nloc = b.st[0], nx = b.st[1];
        if (nloc == 0u) { xcd_barrier_complete(bar, b.x, nloc, nx); b.st[0] = nloc; b.st[1] = nx; }
        const unsigned old = xb_add(&bar[XB_XSUB(b.x)], 1u);
        const unsigned gen = old / nloc;
        if (old + 1u == (gen + 1u) * nloc) {
            __builtin_amdgcn_fence(__ATOMIC_RELEASE, "agent");
            asm volatile("s_waitcnt vmcnt(0)" ::: "memory");
            const unsigned og = xb_add(&bar[XB_TOP], 1u);
            const unsigned tg = og / nx;
            if (og + 1u == (tg + 1u) * nx) xb_add(&bar[XB_TOPGEN], 1u);
            else XB_SPIN(xb_ld(&bar[XB_TOPGEN]) == tg, bar);
            __builtin_amdgcn_fence(__ATOMIC_ACQUIRE, "agent");
            xb_add(&bar[XB_XGEN(b.x)], 1u);
            asm volatile("s_waitcnt vmcnt(0)" ::: "memory");
        } else {
            XB_SPIN(xb_ld(&bar[XB_XGEN(b.x)]) == gen, bar);
            __builtin_amdgcn_fence(__ATOMIC_ACQUIRE, "agent");
            asm volatile("s_waitcnt vmcnt(0)" ::: "memory");
        }
    }
    __syncthreads();
}

constexpr int NWAVES = 8, NTHREADS = 512;
constexpr int RING_BYTES = 131072, LDS_BYTES = 163840, MISC_OFF = LDS_BYTES - 512;
constexpr int CW_BAR = 4096;
constexpr size_t CTL_ZERO_BYTES = 256 * 1024;
struct Args { Ptrs p; int ph_lo, ph_hi; };

struct EpiInProj {
    static constexpr bool PERM = true; static constexpr bool BQUAD = false; static constexpr bool SWAP = true; static constexpr int WHALF = 4;
    static __device__ __forceinline__ int wrow(int R) { return 128 * (R >> 6) + 8 * (R & 15) + ((R >> 4) & 3); }
    bf16_t* PROJ; const float* R;
    __device__ __forceinline__ void operator()(const f32x4 (&acc)[2][2][4][2], const pg8::Unit& u, int wr, int wc, int fr, int fq) const {
        const int row0 = u.pm * 256 + wc * 32 + 4 * fq, col0 = u.pn * 256 + wr * 128 + 8 * fr;
        const bool qk = (u.pn >= 4 && u.pn < 8), isk = (u.pn >= 6 && u.pn < 8), lat = (u.pm >= NCTX / 256);
        const int cgp = col0 >> 9, cin = col0 & 511, rpitch = (cgp < 2) ? 64 : 128;
        bf16_t* colp = PROJ + (cgp < 2 ? proj_blk(cgp, cin >> 6) + (cin & 63) : proj_blk(cgp, cin >> 7) + (cin & 127));
        const int ip0 = 4 * fr;
#pragma unroll
        for (int bj = 0; bj < 2; ++bj)
#pragma unroll
            for (int n = 0; n < 2; ++n)
#pragma unroll
                for (int j = 0; j < 4; ++j) {
                    const int row = row0 + bj * 128 + n * 16 + j;
                    f32x4 v0 = {acc[0][bj][0][n][j], acc[0][bj][1][n][j], acc[0][bj][2][n][j], acc[0][bj][3][n][j]}, v1 = {acc[1][bj][0][n][j], acc[1][bj][1][n][j], acc[1][bj][2][n][j], acc[1][bj][3][n][j]};
                    if (qk) {
                        if (lat) {
                            const int t = (row - NCTX) & (T - 1), pos = (ip0 < 32) ? (t >> 6) : (t & 63);
                            const f32x4* rp = (const f32x4*)(R + (size_t)(pos * 32 + (ip0 & 31)) * 2);
                            const f32x4 c0 = rp[0], c1 = rp[1];
                            f32x4 w0, w1;
                            w0[0] = v0[0] * c0[0] - v0[1] * c0[1]; w0[1] = v0[0] * c0[1] + v0[1] * c0[0];
                            w0[2] = v0[2] * c0[2] - v0[3] * c0[3]; w0[3] = v0[2] * c0[3] + v0[3] * c0[2];
                            w1[0] = v1[0] * c1[0] - v1[1] * c1[1]; w1[1] = v1[0] * c1[1] + v1[1] * c1[0];
                            w1[2] = v1[2] * c1[2] - v1[3] * c1[3]; w1[3] = v1[2] * c1[3] + v1[3] * c1[2];
                            v0 = w0; v1 = w1;
                        }
                        if (isk) { v0 = v0 * 0.08838834764831845f; v1 = v1 * 0.08838834764831845f; }
                    }
                    pg8::u32x4 w; w.x = pg8::cvt_pk_bf16(v0[0], v0[1]); w.y = pg8::cvt_pk_bf16(v0[2], v0[3]); w.z = pg8::cvt_pk_bf16(v1[0], v1[1]); w.w = pg8::cvt_pk_bf16(v1[2], v1[3]);
                    *(pg8::u32x4*)(colp + (size_t)row * rpitch) = w;
                }
    }
};
__device__ __forceinline__ float row16_sum(float v) {
    v += __int_as_float(__builtin_amdgcn_update_dpp(0, __float_as_int(v), 0x128, 0xf, 0xf, false));
    v += __int_as_float(__builtin_amdgcn_update_dpp(0, __float_as_int(v), 0x124, 0xf, 0xf, false));
    v += __int_as_float(__builtin_amdgcn_update_dpp(0, __float_as_int(v), 0x4E, 0xf, 0xf, false));
    v += __int_as_float(__builtin_amdgcn_update_dpp(0, __float_as_int(v), 0xB1, 0xf, 0xf, false));
    return v;
}
struct EpiOutProj {
    static constexpr bool PERM = true; static constexpr bool BQUAD = false; static constexpr bool SWAP = true; static constexpr int WHALF = 64;
    static __device__ __forceinline__ int wrow(int R) { return 128 * (R >> 6) + 4 * (R & 15) + ((R >> 4) & 3); }
    const float* x; const float* MOD; bf16_t* out; float* SSQ;
    __device__ __forceinline__ void operator()(const f32x4 (&acc)[2][2][4][2], const pg8::Unit& u, int wr, int wc, int fr, int fq) const {
        const int row0 = u.pm * 256 + wc * 32 + 4 * fq, col0 = u.pn * 256 + wr * 128 + 4 * fr;
        const float* g1 = MOD + (size_t)(u.pm / (T / 256)) * NMOD + 2 * D + col0;
        const f32x4 gv0 = *(const f32x4*)g1, gv1 = *(const f32x4*)(g1 + 64);
        struct XG { f32x4 v0, v1; };
#define OP_LDX(g, t) do { const float* xp = x + (size_t)(row0 + ((t) >> 3) * 128 + (((t) >> 2) & 1) * 16 + ((t) & 3)) * D + col0; g.v0 = *(const f32x4*)xp; g.v1 = *(const f32x4*)(xp + 64); } while (0)
#define OP_FIN(g, t) do { constexpr int bj = (t) >> 3, n = ((t) >> 2) & 1, j = (t) & 3; const size_t row = (size_t)(row0 + bj * 128 + n * 16 + j); \
            const f32x4 a0 = {acc[0][bj][0][n][j], acc[0][bj][1][n][j], acc[0][bj][2][n][j], acc[0][bj][3][n][j]}, a1 = {acc[1][bj][0][n][j], acc[1][bj][1][n][j], acc[1][bj][2][n][j], acc[1][bj][3][n][j]}; \
            const f32x4 o0 = g.v0 + gv0 * a0, o1 = g.v1 + gv1 * a1; \
            pg8::u32x2 w0, w1; w0.x = pg8::cvt_pk_bf16(o0[0], o0[1]); w0.y = pg8::cvt_pk_bf16(o0[2], o0[3]); w1.x = pg8::cvt_pk_bf16(o1[0], o1[1]); w1.y = pg8::cvt_pk_bf16(o1[2], o1[3]); \
            bf16_t* op = out + row * D + col0; *(pg8::u32x2*)op = w0; *(pg8::u32x2*)(op + 64) = w1; \
            float sq = o0[0] * o0[0] + o0[1] * o0[1] + o0[2] * o0[2] + o0[3] * o0[3] + o1[0] * o1[0] + o1[1] * o1[1] + o1[2] * o1[2] + o1[3] * o1[3]; \
            sq = row16_sum(sq); \
            if (fr == 0) SSQ[row * 16 + u.pn * 2 + wr] = sq; } while (0)
        XG a, b, c, d, e, f, g, h;
        OP_LDX(a, 0); OP_LDX(b, 1); OP_LDX(c, 2); OP_LDX(d, 3); OP_LDX(e, 4); OP_LDX(f, 5); OP_LDX(g, 6); OP_LDX(h, 7);
        OP_FIN(a, 0); OP_LDX(a, 8); OP_FIN(b, 1); OP_LDX(b, 9); OP_FIN(c, 2); OP_LDX(c, 10); OP_FIN(d, 3); OP_LDX(d, 11);
        OP_FIN(e, 4); OP_LDX(e, 12); OP_FIN(f, 5); OP_LDX(f, 13); OP_FIN(g, 6); OP_LDX(g, 14); OP_FIN(h, 7); OP_LDX(h, 15);
        OP_FIN(a, 8); OP_FIN(b, 9); OP_FIN(c, 10); OP_FIN(d, 11);
        OP_FIN(e, 12); OP_FIN(f, 13); OP_FIN(g, 14); OP_FIN(h, 15);
#undef OP_LDX
#undef OP_FIN
    }
};

struct MoeOrderGU {
    const char* H2; const char* W; const int* tile_e; int n0, n1, G, c;
    __device__ bool next(int i, pg8::Unit& u) const {
        int ri, pn;
        if ((G & 63) == 0) { const int x = c & 7, slot = c >> 3, rpg = G >> 4; ri = (i * 8 + x) * rpg + (slot >> 1); pn = slot & 1; }
        else { const int L = i * G + c; ri = L >> 1; pn = L & 1; }
        if (ri >= n0 + n1 + NPART * GPP) return false;
        int q = 0; if (NPART > 1 && ri >= n0 + GPP) { q = 1; ri -= n0 + GPP; }
        const int nq = q ? n1 : n0, rt = (ri < nq) ? ri : RT_ROUTED + (ri - nq), e = (ri < nq) ? tile_e[q * RT_PART + rt] : NE;
        u.pm = q * RT_PART + rt; u.pn = pn; u.aux = e; u.pad = 0; u.A = H2; u.B = W + (size_t)e * (512 * 1024 * 2) + (size_t)pn * (256 * 1024 * 2); return true;
    }
};
struct MoeOrderDown {
    const char* HB; const char* W; const int* tile_e; int n0, n1, G, c;
    __device__ bool next(int i, pg8::Unit& u) const {
        int ri, pn;
        if ((G & 63) == 0) { const int x = c & 7, slot = c >> 3, rpg = G >> 5; ri = (i * 8 + x) * rpg + (slot >> 2); pn = slot & 3; }
        else { const int L = i * G + c; ri = L >> 2; pn = L & 3; }
        if (ri >= n0 + n1 + NPART * GPP) return false;
        ri = n0 + n1 + NPART * GPP - 1 - ri;
        int q = 0; if (NPART > 1 && ri >= n0 + GPP) { q = 1; ri -= n0 + GPP; }
        const int nq = q ? n1 : n0, rt = (ri < nq) ? ri : RT_ROUTED + (ri - nq), e = (ri < nq) ? tile_e[q * RT_PART + rt] : NE;
        u.pm = q * RT_PART + rt; u.pn = pn; u.aux = e; u.pad = 0; u.A = HB + (size_t)u.pm * (256 * 256 * 2); u.B = W + (size_t)e * (1024 * 256 * 2) + (size_t)pn * (64 * 256 * 2); return true;
    }
};
constexpr int MOE_DSC_N = 64, MOE_RL_UNITS = 16;
struct LdsOrderGU {
    const char* H2; const char* W; const LAS int* dsc;
    __device__ bool next(int i, pg8::Unit& u) const {
        if (i >= MOE_DSC_N) return false;
        const int d = __builtin_amdgcn_readfirstlane(dsc[i]); if (d < 0) return false;
        const int e = d >> 20; u.pm = d & 0xffff; u.pn = (d >> 16) & 15; u.aux = e; u.pad = 0; u.A = H2; u.B = W + (size_t)e * (512 * 1024 * 2) + (size_t)u.pn * (256 * 1024 * 2); return true;
    }
};
struct LdsOrderDown {
    const char* HB; const char* W; const LAS int* dsc;
    __device__ bool next(int i, pg8::Unit& u) const {
        if (i >= MOE_DSC_N) return false;
        const int d = __builtin_amdgcn_readfirstlane(dsc[i]); if (d < 0) return false;
        const int e = d >> 20; u.pm = d & 0xffff; u.pn = (d >> 16) & 15; u.aux = e; u.pad = 0; u.A = HB + (size_t)u.pm * (256 * 256 * 2); u.B = W + (size_t)e * (1024 * 256 * 2) + (size_t)u.pn * (64 * 256 * 2); return true;
    }
};
struct EpiGateUp {
    static constexpr bool PERM = true; static constexpr bool BQUAD = false; static constexpr bool SWAP = true; static constexpr int WHALF = 4;
    static __device__ __forceinline__ int wrow(int R) { return 8 * (16 * (R >> 6) + (R & 15)) + ((R >> 4) & 3); }
    bf16_t* HB;
    __device__ __forceinline__ void operator()(const f32x4 (&acc)[2][2][4][2], const pg8::Unit& u, int wr, int wc, int fr, int fq) const {
        bf16_t* hp = HB + (size_t)(u.pm * 256 + wc * 32 + 4 * fq) * DE + u.pn * 128 + wr * 64 + fr * 4;
#pragma unroll
        for (int bj = 0; bj < 2; ++bj)
#pragma unroll
            for (int n = 0; n < 2; ++n)
#pragma unroll
                for (int j = 0; j < 4; ++j) {
                    float h[4];
#pragma unroll
                    for (int m = 0; m < 4; ++m) { const float g = acc[0][bj][m][n][j]; h[m] = g * __builtin_amdgcn_rcpf(1.f + __builtin_amdgcn_exp2f(-1.4426950408889634f * g)) * acc[1][bj][m][n][j]; }
                    pg8::u32x2 w; w.x = pg8::cvt_pk_bf16(h[0], h[1]); w.y = pg8::cvt_pk_bf16(h[2], h[3]);
                    *(pg8::u32x2*)(hp + (size_t)(bj * 128 + n * 16 + j) * DE) = w;
                }
    }
};
__device__ __forceinline__ pg8::u32x4 pair_rows16(pg8::u32x2 a, pg8::u32x2 b, bool odd) {
    const unsigned s0 = odd ? a.x : b.x, s1 = odd ? a.y : b.y;
    const unsigned r0 = (unsigned)__builtin_amdgcn_update_dpp(0, (int)s0, 0xB1, 0xf, 0xf, false), r1 = (unsigned)__builtin_amdgcn_update_dpp(0, (int)s1, 0xB1, 0xf, 0xf, false);
    pg8::u32x4 o; o.x = odd ? r0 : a.x; o.y = odd ? r1 : a.y; o.z = odd ? b.x : r0; o.w = odd ? b.y : r1; return o;
}
struct EpiDown {
    static constexpr bool PERM = true; static constexpr bool BQUAD = false; static constexpr bool SWAP = true; static constexpr int WHALF = 256;
    static __device__ __forceinline__ int wrow(int R) { return 512 * (R & 1) + 32 * (R >> 6) + 4 * ((R & 15) >> 1) + ((R >> 4) & 3); }
    unsigned char* YT;
    __device__ __forceinline__ void operator()(const f32x4 (&acc)[2][2][4][2], const pg8::Unit& u, int wr, int wc, int fr, int fq) const {
        const bool odd = fr & 1;
        unsigned char* tp = YT + ((size_t)(u.pm * 4 + u.pn) * 256 + wc * 32 + 4 * fq) * 256 + wr * 128 + fr * 8 + (odd ? 256 - 8 : 0);
#pragma unroll
        for (int bj = 0; bj < 2; ++bj)
#pragma unroll
            for (int n = 0; n < 2; ++n)
#pragma unroll
                for (int jp = 0; jp < 2; ++jp) {
                    pg8::u32x2 o[2];
#pragma unroll
                    for (int jj = 0; jj < 2; ++jj)
#pragma unroll
                        for (int ai = 0; ai < 2; ++ai) {
                            float v[4];
#pragma unroll
                            for (int m = 0; m < 4; ++m) v[m] = __builtin_amdgcn_fmed3f(acc[ai][bj][m][n][2 * jp + jj], -448.f, 448.f);
                            int w = __builtin_amdgcn_cvt_pk_fp8_f32(v[0], v[1], 0, false); w = __builtin_amdgcn_cvt_pk_fp8_f32(v[2], v[3], w, true); o[jj][ai] = (unsigned)w;
                        }
                    *(pg8::u32x4*)(tp + (bj * 128 + n * 16 + 2 * jp) * 256) = pair_rows16(o[0], o[1], odd);
                }
    }
};

typedef float f32x16 __attribute__((ext_vector_type(16)));
constexpr size_t WS_SNAP = WS_HF;
typedef short v4i16_t __attribute__((ext_vector_type(4)));
__device__ __forceinline__ v4i16_t tr16(const LAS bf16_t* p) { return __builtin_amdgcn_ds_read_tr16_b64_v4i16((LAS v4i16_t*)p); }
__device__ __forceinline__ pg8::bf16x8 cat8(v4i16_t a, v4i16_t b) { return __builtin_shufflevector(a, b, 0, 1, 2, 3, 4, 5, 6, 7); }
__device__ __forceinline__ size_t snap_off(int dv, int dk) { return ((size_t)(dk >> 4) * 128 + dv) * 16 + (dk & 15); }
__device__ __forceinline__ void ret_state_walk(const Ptrs& p, LAS unsigned char* lds, int unit) {
    const int tid = tid_fresh(), lane = tid & 63, w = __builtin_amdgcn_readfirstlane(tid >> 6), fr = lane & 15, fq = lane >> 4, tq = (lane & 15) >> 2, tp = lane & 3;
    const int dvh = unit & 1, dir = (unit >> 1) & 1, hd = (unit >> 2) & 3, b = unit >> 4;
    const float lg = ret_logg(hd), gC = __expf(128.f * lg);
    constexpr int WBUF = 128 * 272 + 128 * 144;
    const bf16_t* PROJ = (const bf16_t*)(p.ws + WS_PROJ);
    bf16_t* SN = (bf16_t*)(p.ws + WS_SNAP) + ((size_t)((b * NH + hd) * 2 + dir) * 32) * 16384;
    f32x4 acc[4];
#pragma unroll
    for (int n = 0; n < 4; ++n) acc[n] = (f32x4){0.f, 0.f, 0.f, 0.f};
    __syncthreads();
    u16x8 kreg[4], vreg[2];
    auto chunk_row0 = [&](int step) -> size_t { if (step < 2) { const int cc = dir == 0 ? step : 1 - step; return (size_t)b * LC + cc * 128; } const int n = dir == 0 ? step - 2 : 31 - (step - 2); return (size_t)NCTX + (size_t)b * T + n * 128; };
    auto prefetch = [&](int step) {
        const size_t r0 = chunk_row0(step);
#pragma unroll
        for (int i = 0; i < 4; ++i) { const int idx = tid + 512 * i, tok = idx >> 4, c = idx & 15; kreg[i] = *(const u16x8*)(PROJ + proj_blk(3, hd) + (r0 + tok) * 128 + c * 8); }
#pragma unroll
        for (int i = 0; i < 2; ++i) { const int idx = tid + 512 * i, tok = idx >> 3, c = idx & 7; vreg[i] = *(const u16x8*)(PROJ + proj_blk(4, hd) + (r0 + tok) * 128 + dvh * 64 + c * 8); }
    };
    prefetch(0);
    for (int step = 0; step < 34; ++step) {
        LAS bf16_t* KL = (LAS bf16_t*)(lds + (step & 1) * WBUF);
        LAS bf16_t* VL = (LAS bf16_t*)(lds + (step & 1) * WBUF + 128 * 272);
#pragma unroll
        for (int i = 0; i < 4; ++i) { const int idx = tid + 512 * i, tok = idx >> 4, c = idx & 15; *(LAS u16x8*)(KL + tok * 136 + c * 8) = kreg[i]; }
#pragma unroll
        for (int i = 0; i < 2; ++i) { const int idx = tid + 512 * i, tok = idx >> 3, c = idx & 7; const float wt = __expf((float)(dir == 0 ? 127 - tok : tok) * lg);
            pg8::u32x4 o; o.x = pg8::cvt_pk_bf16(bf2f(vreg[i][0]) * wt, bf2f(vreg[i][1]) * wt); o.y = pg8::cvt_pk_bf16(bf2f(vreg[i][2]) * wt, bf2f(vreg[i][3]) * wt);
            o.z = pg8::cvt_pk_bf16(bf2f(vreg[i][4]) * wt, bf2f(vreg[i][5]) * wt); o.w = pg8::cvt_pk_bf16(bf2f(vreg[i][6]) * wt, bf2f(vreg[i][7]) * wt);
            *(LAS pg8::u32x4*)(VL + tok * 72 + c * 8) = o; }
        if (step + 1 < 34) prefetch(step + 1);
        if (step >= 2) {
            const int n = dir == 0 ? step - 2 : 31 - (step - 2);
            bf16_t* dst = SN + (size_t)n * 16384;
#pragma unroll
            for (int nn = 0; nn < 4; ++nn) { pg8::u32x2 o; o.x = pg8::cvt_pk_bf16(acc[nn][0], acc[nn][1]); o.y = pg8::cvt_pk_bf16(acc[nn][2], acc[nn][3]);
                *(pg8::u32x2*)(dst + snap_off(dvh * 64 + 16 * nn + fr, 16 * w + 4 * fq)) = o; }
        }
#pragma unroll
        for (int nn = 0; nn < 4; ++nn) acc[nn] = acc[nn] * gC;
        __syncthreads();
#pragma unroll
        for (int s4 = 0; s4 < 4; ++s4) {
            const int tb = 32 * s4 + 8 * fq + tq;
            const pg8::bf16x8 a = cat8(tr16(KL + tb * 136 + 16 * w + 4 * tp), tr16(KL + (tb + 4) * 136 + 16 * w + 4 * tp));
#pragma unroll
            for (int nn = 0; nn < 4; ++nn) { const pg8::bf16x8 bb = cat8(tr16(VL + tb * 72 + 16 * nn + 4 * tp), tr16(VL + (tb + 4) * 72 + 16 * nn + 4 * tp)); acc[nn] = __builtin_amdgcn_mfma_f32_16x16x32_bf16(a, bb, acc[nn], 0, 0, 0); }
        }
    }
    __syncthreads();
}
__device__ __forceinline__ void ret_chunk_out(const Ptrs& p, LAS unsigned char* lds, int unit, int next_unit, bool first) {
    const int tid = tid_fresh(), lane = tid & 63, w = __builtin_amdgcn_readfirstlane(tid >> 6), r = lane & 31, h = lane >> 5, blk = (lane >> 4) & 1, tq = (lane & 15) >> 2, tp = lane & 3;
    const int n = unit & 31, hd = (unit >> 5) & 3, b = unit >> 7, qb = w & 3, dvh = w >> 2;
    const float lg = ret_logg(hd);
    LAS bf16_t* KL = (LAS bf16_t*)lds;
    LAS bf16_t* VL = (LAS bf16_t*)(lds + 128 * 272);
    LAS float* RS = (LAS float*)(lds + 128 * 272 + 128 * 320);
    const size_t crow = (size_t)NCTX + (size_t)b * T + (size_t)n * 128;
    const bf16_t* PJ = (const bf16_t*)(p.ws + WS_PROJ);
    const bf16_t* Qb = PJ + proj_blk(2, hd) + crow * 128; const bf16_t* Kb = PJ + proj_blk(3, hd) + crow * 128; const bf16_t* Vb = PJ + proj_blk(4, hd) + crow * 128; const bf16_t* Gb = PJ + proj_blk(5, hd) + crow * 128;
    const bf16_t* SNf = (const bf16_t*)(p.ws + WS_SNAP) + ((size_t)((b * NH + hd) * 2 + 0) * 32 + n) * 16384;
    const bf16_t* SNb = SNf + (size_t)32 * 16384;
    LAS unsigned char* SNL = lds + 76800;
    auto snap_dma = [&](int un) {
        const int n2 = un & 31, hd2 = (un >> 5) & 3, b2 = un >> 7;
        const char* src = (const char*)((const bf16_t*)(p.ws + WS_SNAP) + ((size_t)((b2 * NH + hd2) * 2 + 0) * 32 + n2) * 16384);
#pragma unroll
        for (int k = 0; k < 8; ++k) { const unsigned o = (unsigned)(k * 512 + tid) * 16u;
            __builtin_amdgcn_global_load_lds((const unsigned*)(src + (size_t)(o >> 15) * ((size_t)32 * 16384 * 2) + (o & 32767u)), (LAS unsigned*)(SNL + (k * 512 + w * 64) * 16), 16, 0, 0); }
    };
    if (first) snap_dma(unit);
    pg8::bf16x8 qf[8];
#pragma unroll
    for (int s = 0; s < 8; ++s) qf[s] = *(const pg8::bf16x8*)(Qb + (qb * 32 + r) * 128 + 16 * s + 8 * h);
    const int rw = lane >> 3, cw = lane & 7;
    u16x8 kvr[4], vvr[4];
#pragma unroll
    for (int i = 0; i < 4; ++i) { const int idx = tid + 512 * i, tok = idx >> 4, c = idx & 15; kvr[i] = *(const u16x8*)(Kb + tok * 128 + c * 8); vvr[i] = *(const u16x8*)(Vb + tok * 128 + c * 8); }
    asm volatile("s_waitcnt vmcnt(0)" ::: "memory");
    __syncthreads();
#pragma unroll
    for (int i = 0; i < 4; ++i) { const int idx = tid + 512 * i, tok = idx >> 4, c = idx & 15; *(LAS u16x8*)(KL + tok * 136 + c * 8) = kvr[i]; *(LAS u16x8*)(VL + tok * 160 + c * 8) = vvr[i]; }
    f32x16 Z[2];
#pragma unroll
    for (int t = 0; t < 2; ++t)
#pragma unroll
        for (int e = 0; e < 16; ++e) Z[t][e] = 0.f;
#pragma unroll
    for (int t = 0; t < 2; ++t)
#pragma unroll
        for (int s = 0; s < 8; ++s) { const pg8::bf16x8 sf = *(const LAS pg8::bf16x8*)(SNL + snap_off(dvh * 64 + t * 32 + r, 16 * s + 8 * h) * 2); Z[t] = __builtin_amdgcn_mfma_f32_32x32x16_bf16(qf[s], sf, Z[t], 0, 0, 0); }
#pragma unroll
    for (int e = 0; e < 16; ++e) { const int i = qb * 32 + (e & 3) + 8 * (e >> 2) + 4 * h; const float ratio = __expf((float)(2 * i + 1 - 128) * lg); Z[0][e] *= ratio; Z[1][e] *= ratio; }
#pragma unroll
    for (int t = 0; t < 2; ++t)
#pragma unroll
        for (int s = 0; s < 8; ++s) { const pg8::bf16x8 sb = *(const LAS pg8::bf16x8*)(SNL + 32768 + snap_off(dvh * 64 + t * 32 + r, 16 * s + 8 * h) * 2); Z[t] = __builtin_amdgcn_mfma_f32_32x32x16_bf16(qf[s], sb, Z[t], 0, 0, 0); }
#pragma unroll
    for (int e = 0; e < 16; ++e) { const int i = qb * 32 + (e & 3) + 8 * (e >> 2) + 4 * h; const float xb = __expf((float)(128 - i) * lg); Z[0][e] *= xb; Z[1][e] *= xb; }
    __syncthreads();
    if (next_unit >= 0) snap_dma(next_unit);
    u16x8 g8[4];
#pragma unroll
    for (int i = 0; i < 4; ++i) g8[i] = *(const u16x8*)(Gb + (unsigned)((qb * 32 + 8 * i + rw) * 128 + dvh * 64 + cw * 8));
#pragma unroll
    for (int kb = 0; kb < 4; ++kb) {
        f32x16 X;
#pragma unroll
        for (int e = 0; e < 16; ++e) X[e] = 0.f;
#pragma unroll
        for (int s = 0; s < 8; ++s) { const pg8::bf16x8 a = *(const LAS pg8::bf16x8*)(KL + (32 * kb + r) * 136 + 16 * s + 8 * h); X = __builtin_amdgcn_mfma_f32_32x32x16_bf16(a, qf[s], X, 0, 0, 0); }
        const int iq = qb * 32 + r;
#pragma unroll
        for (int e = 0; e < 16; ++e) { const int j = 32 * kb + (e & 3) + 8 * (e >> 2) + 4 * h; const int dd = iq > j ? iq - j : j - iq; X[e] *= __expf((float)dd * lg); }
        pg8::bf16x8 pa[2];
#pragma unroll
        for (int s2 = 0; s2 < 2; ++s2) { pg8::u32x4 t4; t4.x = pg8::cvt_pk_bf16(X[8 * s2 + 0], X[8 * s2 + 1]); t4.y = pg8::cvt_pk_bf16(X[8 * s2 + 2], X[8 * s2 + 3]); t4.z = pg8::cvt_pk_bf16(X[8 * s2 + 4], X[8 * s2 + 5]); t4.w = pg8::cvt_pk_bf16(X[8 * s2 + 6], X[8 * s2 + 7]);
            pa[s2] = __builtin_bit_cast(pg8::bf16x8, t4); }
        v4i16_t va[2][2], vc[2][2];
#pragma unroll
        for (int t = 0; t < 2; ++t)
#pragma unroll
            for (int s2 = 0; s2 < 2; ++s2) {
                const unsigned ad = (unsigned)(size_t)(VL + (32 * kb + 16 * s2 + 4 * h + tq) * 160 + dvh * 64 + t * 32 + 16 * blk + 4 * tp);
                asm volatile("ds_read_b64_tr_b16 %0, %2\n\tds_read_b64_tr_b16 %1, %2 offset:2560" : "=&v"(va[t][s2]), "=&v"(vc[t][s2]) : "v"(ad) : "memory");
            }
        asm volatile("s_waitcnt lgkmcnt(0)" ::: "memory");
        __builtin_amdgcn_sched_barrier(0);
#pragma unroll
        for (int t = 0; t < 2; ++t)
#pragma unroll
            for (int s2 = 0; s2 < 2; ++s2) Z[t] = __builtin_amdgcn_mfma_f32_32x32x16_bf16(pa[s2], cat8(va[t][s2], vc[t][s2]), Z[t], 0, 0, 0);
    }
    float rs[16];
#pragma unroll
    for (int e = 0; e < 16; ++e) { float v = Z[0][e] * Z[0][e] + Z[1][e] * Z[1][e];
        v += __shfl_xor(v, 1); v += __shfl_xor(v, 2); v += __shfl_xor(v, 4); v += __shfl_xor(v, 8); v += __shfl_xor(v, 16); rs[e] = v; }
    if (r == 0) {
#pragma unroll
        for (int e = 0; e < 16; ++e) RS[dvh * 128 + qb * 32 + (e & 3) + 8 * (e >> 2) + 4 * h] = rs[e];
    }
    __syncthreads();
    bf16_t* Y = (bf16_t*)(p.ws + WS_Y) + ((size_t)b * T + (size_t)n * 128) * D + DL + hd * 128;
    LAS float* Sw = (LAS float*)(lds + w * 8704);
#pragma unroll
    for (int e = 0; e < 16; ++e) {
        const int rl = (e & 3) + 8 * (e >> 2) + 4 * h, row = qb * 32 + rl;
        const float rstd = rsqrtf((RS[row] + RS[128 + row]) * (1.f / 128.f) + EPS);
        Sw[rl * 68 + r] = Z[0][e] * rstd; Sw[rl * 68 + 32 + r] = Z[1][e] * rstd;
    }
    asm volatile("s_waitcnt lgkmcnt(0)" ::: "memory");
#pragma unroll
    for (int i = 0; i < 4; ++i) {
        const int rl = 8 * i + rw;
        const f32x4 z0 = *(const LAS f32x4*)(Sw + rl * 68 + cw * 8), z1 = *(const LAS f32x4*)(Sw + rl * 68 + cw * 8 + 4);
        float yv[8];
#pragma unroll
        for (int k = 0; k < 8; ++k) { const float g = bf2f(g8[i][k]); yv[k] = (k < 4 ? z0[k] : z1[k - 4]) * (g * __builtin_amdgcn_rcpf(1.f + __builtin_amdgcn_exp2f(-1.4426950408889634f * g))); }
        pg8::u32x4 o; o.x = pg8::cvt_pk_bf16(yv[0], yv[1]); o.y = pg8::cvt_pk_bf16(yv[2], yv[3]); o.z = pg8::cvt_pk_bf16(yv[4], yv[5]); o.w = pg8::cvt_pk_bf16(yv[6], yv[7]);
        *(pg8::u32x4*)(Y + (unsigned)((qb * 32 + rl) * D + dvh * 64 + cw * 8)) = o;
    }
}

constexpr size_t WS_SSQ = 7 * MiB;
constexpr size_t WS_WRT = 125 * MiB;
constexpr size_t WS_WLRU = 124 * MiB;
constexpr size_t WS_HFB = 928 * MiB;
__device__ __forceinline__ void lru_unit(const Ptrs& p, LAS unsigned char* lds, int unit) {
    const int tid = tid_fresh(), lane = tid & 63, w = __builtin_amdgcn_readfirstlane(tid >> 6), r = lane & 31, h = lane >> 5;
    const int nh = unit & 1, hb = (unit >> 1) & 7, b = unit >> 4;
    const int ch = hb * 64 + nh * 32 + r;
    LAS float* cwl = (LAS float*)lds;
    LAS float* comp = (LAS float*)(lds + 2048);
    const bf16_t* PROJ = (const bf16_t*)(p.ws + WS_PROJ);
    bf16_t* HF = (bf16_t*)(p.ws + WS_HFB);
    bf16_t* Y = (bf16_t*)(p.ws + WS_Y);
    __syncthreads();
    if (tid < 320) { const int k = tid >> 6, c = tid & 63; cwl[tid] = (k < 4) ? p.conv_w[k * DL + hb * 64 + c] : p.conv_b[hb * 64 + c]; }
    __syncthreads();
    for (int dir = 0; dir < 2; ++dir) {
        const bf16_t* WL = (const bf16_t*)(p.ws + WS_WLRU) + ((size_t)(dir * NBLK + hb) * 2) * 4096;
        LAS bf16_t* wl = (LAS bf16_t*)(lds + 147456);
        __syncthreads();
        { const int gate = tid >> 8, o = (tid >> 3) & 31, c = tid & 7; *(LAS u16x8*)(wl + (gate * 32 + o) * 72 + c * 8) = *(const u16x8*)(WL + (size_t)gate * 4096 + (size_t)(nh * 32 + o) * 64 + c * 8); }
        const float br = p.lru_b_rec[dir * DL + ch], bi = p.lru_b_in[dir * DL + ch];
        const float cch = -8.f * log1pf(__expf(-p.lru_lambda[dir * DL + ch])) * 1.4426950408889634f;
        float round_carry = 0.f;
        auto fetch_xa = [&](int sgx, int par) {
            const bool ic = sgx < 4; const int tlx = ic ? (dir == 0 ? sgx : 3 - sgx) : (dir == 0 ? sgx - 4 : 63 - (sgx - 4)), t0x = tlx * 64, lenx = ic ? LC : T;
            const size_t rbx = ic ? (size_t)b * LC : (size_t)NCTX + (size_t)b * T;
            LAS bf16_t* xd = (LAS bf16_t*)(lds + 8192 + (w * 2 + par) * 8704);
#pragma unroll
            for (int i = 0; i < 9; ++i) { const int row = 8 * i + (lane >> 3); int tt = t0x - 2 + row; tt = tt < 0 ? 0 : (tt >= lenx ? lenx - 1 : tt);
                if (row < 67) __builtin_amdgcn_global_load_lds((const unsigned*)(PROJ + proj_blk(0, hb) + (rbx + tt) * 64 + (((lane & 7) ^ ((lane >> 3) & 7)) * 8)), (LAS unsigned*)(xd + i * 512), 16, 0, 0); }
        };
        __syncthreads();
        fetch_xa(w, 0);
        for (int rd = 0; rd < 9; ++rd) {
            const int sg = rd * 8 + w; const bool active = sg < 68;
            f32x16 P[2], Q[2]; float Ap = 1.f, Bp = 0.f;
            bool is_ctx = false; int t0 = 0;
            if (active) {
                is_ctx = sg < 4; const int tl = is_ctx ? (dir == 0 ? sg : 3 - sg) : (dir == 0 ? sg - 4 : 63 - (sg - 4)); t0 = tl * 64;
                const int len = is_ctx ? LC : T; const size_t rowbase = is_ctx ? (size_t)b * LC : (size_t)NCTX + (size_t)b * T;
                LAS bf16_t* xt = (LAS bf16_t*)(lds + 8192 + (w * 2 + (rd & 1)) * 8704);
                if (sg + 8 < 68) { fetch_xa(sg + 8, (rd + 1) & 1); asm volatile("s_waitcnt vmcnt(9)" ::: "memory"); }
                else asm volatile("s_waitcnt vmcnt(0)" ::: "memory");
                if (t0 == 0 && lane < 16) *(LAS u16x8*)(xt + lane * 8) = (u16x8){0, 0, 0, 0, 0, 0, 0, 0};
                if (t0 + 64 == len && lane < 8) *(LAS u16x8*)(xt + 66 * 64 + lane * 8) = (u16x8){0, 0, 0, 0, 0, 0, 0, 0};
                asm volatile("s_waitcnt lgkmcnt(0)" ::: "memory");
#pragma unroll
                for (int m = 0; m < 2; ++m) {
                    const int rho = 32 * m + r, trow = dir == 0 ? rho : 63 - rho;
                    pg8::bf16x8 af[4];
#pragma unroll
                    for (int s4 = 0; s4 < 4; ++s4) {
                        const int c0 = 16 * s4 + 8 * h; float u8[8];
                        { const f32x4 b0 = *(const LAS f32x4*)(cwl + 256 + c0), b1 = *(const LAS f32x4*)(cwl + 256 + c0 + 4); u8[0] = b0[0]; u8[1] = b0[1]; u8[2] = b0[2]; u8[3] = b0[3]; u8[4] = b1[0]; u8[5] = b1[1]; u8[6] = b1[2]; u8[7] = b1[3]; }
#pragma unroll
                        for (int d = 0; d < 4; ++d) { const int xrow = trow + d; const u16x8 xv = *(const LAS u16x8*)(xt + xrow * 64 + (((c0 >> 3) ^ (xrow & 7)) << 3));
                            const f32x4 w0 = *(const LAS f32x4*)(cwl + d * 64 + c0), w1 = *(const LAS f32x4*)(cwl + d * 64 + c0 + 4);
#pragma unroll
                            for (int j = 0; j < 4; ++j) { u8[j] += w0[j] * bf2f(xv[j]); u8[4 + j] += w1[j] * bf2f(xv[4 + j]); } }
                        pg8::u32x4 t4; t4.x = pg8::cvt_pk_bf16(u8[0], u8[1]); t4.y = pg8::cvt_pk_bf16(u8[2], u8[3]); t4.z = pg8::cvt_pk_bf16(u8[4], u8[5]); t4.w = pg8::cvt_pk_bf16(u8[6], u8[7]);
                        af[s4] = __builtin_bit_cast(pg8::bf16x8, t4);
                    }
                    f32x16 R, I, U;
#pragma unroll
                    for (int e = 0; e < 16; ++e) { R[e] = 0.f; I[e] = 0.f; U[e] = 0.f; }
#pragma unroll
                    for (int s4 = 0; s4 < 4; ++s4) { const pg8::bf16x8 wrf = *(const LAS pg8::bf16x8*)(wl + r * 72 + 16 * s4 + 8 * h), wif = *(const LAS pg8::bf16x8*)(wl + (32 + r) * 72 + 16 * s4 + 8 * h);
                        R = __builtin_amdgcn_mfma_f32_32x32x16_bf16(af[s4], wrf, R, 0, 0, 0); I = __builtin_amdgcn_mfma_f32_32x32x16_bf16(af[s4], wif, I, 0, 0, 0); }
                    pg8::bf16x8 idf[2];
                    { int lr = lane; asm volatile("" : "+v"(lr)); const int r_ = lr & 31, h_ = lr >> 5;
#pragma unroll
                      for (int sp = 0; sp < 2; ++sp)
#pragma unroll
                          for (int j = 0; j < 8; ++j) idf[sp][j] = (16 * sp + 8 * h_ + j == r_) ? (short)0x3F80 : (short)0; }
                    if (nh == 0) { U = __builtin_amdgcn_mfma_f32_32x32x16_bf16(af[0], idf[0], U, 0, 0, 0); U = __builtin_amdgcn_mfma_f32_32x32x16_bf16(af[1], idf[1], U, 0, 0, 0); }
                    else         { U = __builtin_amdgcn_mfma_f32_32x32x16_bf16(af[2], idf[0], U, 0, 0, 0); U = __builtin_amdgcn_mfma_f32_32x32x16_bf16(af[3], idf[1], U, 0, 0, 0); }
                    float Ar[4], Br[4];
#pragma unroll
                    for (int g = 0; g < 4; ++g) {
                        float pp = 1.f, qq = 0.f;
#pragma unroll
                        for (int e4 = 0; e4 < 4; ++e4) { const int e = 4 * g + e4;
                            const float rs = __builtin_amdgcn_rcpf(1.f + __builtin_amdgcn_exp2f(-1.4426950408889634f * (R[e] + br)));
                            const float is = __builtin_amdgcn_rcpf(1.f + __builtin_amdgcn_exp2f(-1.4426950408889634f * (I[e] + bi)));
                            const float a = __builtin_amdgcn_exp2f(cch * rs);
                            const float bb = __builtin_amdgcn_sqrtf(fmaxf(1.f - a * a, 0.f)) * (is * U[e]);
                            pp = a * pp; qq = a * qq + bb; P[m][e] = pp; Q[m][e] = qq; }
                        Ar[g] = pp; Br[g] = qq;
                    }
#pragma unroll
                    for (int g = 0; g < 4; ++g) {
                        const float Ao = __shfl_xor(Ar[g], 32), Bo = __shfl_xor(Br[g], 32);
                        const float A0 = h == 0 ? Ar[g] : Ao, B0 = h == 0 ? Br[g] : Bo, A1 = h == 0 ? Ao : Ar[g], B1 = h == 0 ? Bo : Br[g];
                        const float Am = A0 * Ap, Bm = A0 * Bp + B0;
                        const float Aq = h == 0 ? Ap : Am, Bq = h == 0 ? Bp : Bm;
#pragma unroll
                        for (int e4 = 0; e4 < 4; ++e4) { const int e = 4 * g + e4; const float pe = P[m][e]; Q[m][e] = pe * Bq + Q[m][e]; P[m][e] = pe * Aq; }
                        Ap = A1 * Am; Bp = A1 * Bm + B1;
                    }
                }
            }
            LAS float* cb = comp + (rd & 1) * 512;
            if (h == 0) { cb[(w * 32 + r) * 2] = Ap; cb[(w * 32 + r) * 2 + 1] = Bp; }
            __syncthreads();
            float st = round_carry, mine = 0.f;
#pragma unroll
            for (int ww = 0; ww < 8; ++ww) { const float A = cb[(ww * 32 + r) * 2], Bv = cb[(ww * 32 + r) * 2 + 1]; if (ww == w) mine = st; st = A * st + Bv; }
            round_carry = st;
            if (active && !is_ctx) {
                const int tl0 = dir == 0 ? t0 + 4 * h : t0 + 63 - 4 * h, sgn = dir == 0 ? 1 : -1;
                unsigned short* HFb = HF + (size_t)b * T * DL; const bf16_t* GAb = PROJ + proj_blk(1, hb) + ((size_t)NCTX + (size_t)b * T) * 64; bf16_t* Yb = Y + (size_t)b * T * D;
                if (dir == 0) {
#pragma unroll
                    for (int m = 0; m < 2; ++m)
#pragma unroll
                        for (int e = 0; e < 16; ++e) { const int tok = tl0 + sgn * (32 * m + (e & 3) + 8 * (e >> 2)); const float hv = P[m][e] * mine + Q[m][e];
                            HFb[(unsigned)(tok * DL + ch)] = (unsigned short)pg8::cvt_pk_bf16(hv, hv); }
                } else {
#pragma unroll
                    for (int m = 0; m < 2; ++m) {
                        unsigned short hfv[16], gav[16];
#pragma unroll
                        for (int e = 0; e < 16; ++e) { const int tok = tl0 + sgn * (32 * m + (e & 3) + 8 * (e >> 2)); hfv[e] = HFb[(unsigned)(tok * DL + ch)]; gav[e] = GAb[(unsigned)(tok * 64 + (ch & 63))]; }
#pragma unroll
                        for (int e = 0; e < 16; ++e) { const int tok = tl0 + sgn * (32 * m + (e & 3) + 8 * (e >> 2)); const float hv = P[m][e] * mine + Q[m][e];
                            const float ga = bf2f(gav[e]);
                            const float uu = 0.7978845608028654f * (ga + 0.044715f * ga * ga * ga), th = 1.f - 2.f * __builtin_amdgcn_rcpf(1.f + __builtin_amdgcn_exp2f(2.f * 1.4426950408889634f * uu));
                            const float yv = (bf2f(hfv[e]) + hv) * (0.5f * ga * (1.f + th));
                            Yb[(unsigned)(tok * D + ch)] = (unsigned short)pg8::cvt_pk_bf16(yv, yv); }
                    }
                }
            }
        }
        __syncthreads();
        asm volatile("s_waitcnt vmcnt(0)" ::: "memory");
        __syncthreads();
    }
}
struct TItem { const float* src; const float* src2; bf16_t* dst; int K, N, ld, mode, item; float scale; };
__device__ __forceinline__ void p0_item_load(const TItem& t, int lane, f32x4 (&v)[8], int& nl0, int& nls) {
    const int nblk = t.N / 32, kb = t.item / nblk, nb = t.item % nblk, k0 = 64 * kb, n0 = 32 * nb, c = lane & 7;
    const float* src = t.src; int col = n0 + 4 * c; nl0 = 4 * c; nls = 1;
    if (t.mode == 1) { const int grp = n0 >> 9; if (grp == 2 || grp == 3) { const int hh = (n0 & 511) >> 7, ip0 = (n0 & 127) >> 1, s1 = c >> 2, i0 = 4 * (c & 3);
            const int d = (ip0 < 32) ? (ip0 + i0 + 32 * s1) : (64 + (ip0 - 32) + i0 + 32 * s1); col = (grp << 9) + hh * 128 + d; nl0 = 2 * i0 + s1; nls = 2; } }
    if (t.mode == 2) { col = 4 * (n0 >> 3) + 4 * (c >> 1); if (c & 1) src = t.src2; }
#pragma unroll
    for (int i = 0; i < 8; ++i) v[i] = *(const f32x4*)(src + (size_t)(k0 + 8 * i + (lane >> 3)) * t.ld + col);
}
__device__ __forceinline__ void p0_item_store(const TItem& t, int lane, const f32x4 (&v)[8], int nl0, int nls, LAS float* scr) {
    const int nblk = t.N / 32, kb = t.item / nblk, nb = t.item % nblk, k0 = 64 * kb, n0 = 32 * nb;
#pragma unroll
    for (int i = 0; i < 8; ++i) { const int kk = 8 * i + (lane >> 3);
#pragma unroll
        for (int j = 0; j < 4; ++j) scr[kk * 33 + nl0 + nls * j] = v[i][j]; }
    asm volatile("s_waitcnt lgkmcnt(0)" ::: "memory");
    const int c = lane & 7;
#pragma unroll
    for (int j = 0; j < 4; ++j) { const int nn = (lane >> 3) + 8 * j; const LAS float* sp = scr + (8 * c) * 33 + nn;
        const float sc = t.scale; pg8::u32x4 o; o.x = pg8::cvt_pk_bf16(sp[0 * 33] * sc, sp[1 * 33] * sc); o.y = pg8::cvt_pk_bf16(sp[2 * 33] * sc, sp[3 * 33] * sc); o.z = pg8::cvt_pk_bf16(sp[4 * 33] * sc, sp[5 * 33] * sc); o.w = pg8::cvt_pk_bf16(sp[6 * 33] * sc, sp[7 * 33] * sc);
        *(pg8::u32x4*)(t.dst + (size_t)(n0 + nn) * t.K + k0 + 8 * c) = o; }
    asm volatile("s_waitcnt lgkmcnt(0)" ::: "memory");
}
__device__ __forceinline__ bool p0_item_decode(const Ptrs& p, int it, TItem& t) {
    constexpr int I_IN = (D / 64) * (NPROJ / 32), I_OUT = (D / 64) * (D / 32), I_GU = (D / 64) * (512 / 32), I_DN = (DE / 64) * (D / 32);
    constexpr int NITEMS = I_IN + I_OUT + (NE + 1) * (I_GU + I_DN);
    if (it >= NITEMS) return false;
    int r = it; t.src2 = nullptr; t.scale = 1.f;
    if (r < I_IN) { t.src = p.w_in; t.dst = (bf16_t*)(p.ws + WS_WINT); t.K = D; t.N = NPROJ; t.ld = NPROJ; t.mode = 1; t.item = r; return true; } r -= I_IN;
    if (r < I_OUT) { t.src = p.w_out; t.dst = (bf16_t*)(p.ws + WS_WOUTT); t.K = D; t.N = D; t.ld = D; t.mode = 0; t.item = r; return true; } r -= I_OUT;
    if (r < (NE + 1) * I_GU) { const int e = r / I_GU; t.item = r % I_GU; t.src = e < NE ? p.w_exp_gate + (size_t)e * D * DE : p.w_sh_gate; t.src2 = e < NE ? p.w_exp_up + (size_t)e * D * DE : p.w_sh_up;
        t.dst = (bf16_t*)(p.ws + WS_WGUT) + (size_t)e * 512 * D; t.K = D; t.N = 512; t.ld = DE; t.mode = 2; return true; } r -= (NE + 1) * I_GU;
    { const int e = r / I_DN; t.item = r % I_DN; t.src = e < NE ? p.w_exp_down + (size_t)e * DE * D : p.w_sh_down; t.dst = (bf16_t*)(p.ws + WS_WDT) + (size_t)e * D * DE; t.K = DE; t.N = D; t.ld = D; t.mode = 0; t.scale = 16.f; return true; }
}
__device__ __forceinline__ void p0_prologue(const Ptrs& p, LAS unsigned char* lds, int G) {
    const int tid = tid_fresh(), lane = tid & 63, w = __builtin_amdgcn_readfirstlane(tid >> 6);
    if ((int)blockIdx.x < NMOD / 64) {
        LAS float* sil = (LAS float*)(lds + 40960);
        for (int i = tid; i < 17 * D; i += NTHREADS) { const int r = i >> 10, k = i & 1023; const float cv = (r < 16) ? p.c[r * D + k] : p.c_ctx[k]; sil[k * 20 + r] = siluf_(cv); }
        __syncthreads();
        for (int it = blockIdx.x; it < NMOD / 64; it += G) {
            LAS float* red = (LAS float*)lds;
            const int col = it * 64 + lane;
            float acc[17];
#pragma unroll
            for (int r = 0; r < 17; ++r) acc[r] = 0.f;
            for (int k0 = w * 128; k0 < w * 128 + 128; k0 += 16) {
                float wv[16];
#pragma unroll
                for (int i = 0; i < 16; ++i) wv[i] = p.w_mod[(size_t)(k0 + i) * NMOD + col];
#pragma unroll
                for (int i = 0; i < 16; ++i) { const int k = k0 + i;
                    const f32x4 s0 = *(const LAS f32x4*)(sil + k * 20), s1 = *(const LAS f32x4*)(sil + k * 20 + 4), s2 = *(const LAS f32x4*)(sil + k * 20 + 8), s3 = *(const LAS f32x4*)(sil + k * 20 + 12); const float s4 = sil[k * 20 + 16];
#pragma unroll
                    for (int j = 0; j < 4; ++j) { acc[j] += s0[j] * wv[i]; acc[4 + j] += s1[j] * wv[i]; acc[8 + j] += s2[j] * wv[i]; acc[12 + j] += s3[j] * wv[i]; }
                    acc[16] += s4 * wv[i]; }
            }
#pragma unroll
            for (int r = 0; r < 17; ++r) red[(w * 17 + r) * 64 + lane] = acc[r];
            __syncthreads();
            float* MOD = (float*)(p.ws + WS_MOD);
            for (int o = tid; o < 17 * 64; o += NTHREADS) { const int r = o >> 6, cl = o & 63; float sacc = p.b_mod[it * 64 + cl];
#pragma unroll
                for (int ww = 0; ww < 8; ++ww) sacc += red[(ww * 17 + r) * 64 + cl];
                MOD[r * NMOD + it * 64 + cl] = sacc; }
            __syncthreads();
        }
    }
    __syncthreads();
    const int gw = blockIdx.x * NWAVES + w, NGW = G * NWAVES, gt = blockIdx.x * NTHREADS + tid, NGT = G * NTHREADS;
    for (int i = gt; i < 64 * 32; i += NGT) { const int fi = i & 31, pos = i >> 5; const float ang = (float)pos * powf(10000.f, -(float)fi / 32.f); float* R = (float*)(p.ws + WS_ROPE); R[2 * i] = cosf(ang); R[2 * i + 1] = sinf(ang); }
    for (int idx = gt; idx < 2 * NBLK * 2 * 4096; idx += NGT) { const int in = idx & 63, out = (idx >> 6) & 63, gate = (idx >> 12) & 1, hb = (idx >> 13) & 7, dir = idx >> 16;
        const float* src = gate ? p.lru_w_in : p.lru_w_rec; ((bf16_t*)(p.ws + WS_WLRU))[idx] = f2bf(src[(((size_t)dir * NBLK + hb) * 64 + in) * 64 + out]); }
    for (int idx = gt; idx < NE * D; idx += NGT) { const int e = idx >> 10, k = idx & 1023; const float wv = p.w_router[(size_t)k * NE + e]; const bf16_t hi = f2bf(wv);
        ((bf16_t*)(p.ws + WS_WRT))[idx] = hi; ((bf16_t*)(p.ws + WS_WRT))[NE * D + idx] = f2bf(wv - bf2f(hi)); }
    LAS float* scr = (LAS float*)(lds + w * 8448);
    const int nmw = (G > NMOD / 64) ? NMOD / 64 : 0, nsl = ((int)blockIdx.x < nmw) ? 1 : 2;
    const int sbase = ((int)blockIdx.x < nmw) ? (int)blockIdx.x * NWAVES + w : nmw * NWAVES + (((int)blockIdx.x - nmw) * NWAVES + w) * 2, NV = nmw * NWAVES + (G - nmw) * NWAVES * 2;
    auto item_of = [&](int k) -> int { return sbase + (k % nsl) + (k / nsl) * NV; };
    TItem tc, tn; f32x4 vc[8], vn[8]; int c0 = 0, c1 = 1, n0 = 0, n1 = 1;
    bool have = p0_item_decode(p, item_of(0), tc);
    if (have) p0_item_load(tc, lane, vc, c0, c1);
    for (int k = 0; have; ++k) {
        const bool hn = p0_item_decode(p, item_of(k + 1), tn);
        if (hn) p0_item_load(tn, lane, vn, n0, n1);
        p0_item_store(tc, lane, vc, c0, c1, scr);
        tc = tn; c0 = n0; c1 = n1; have = hn;
#pragma unroll
        for (int i = 0; i < 8; ++i) vc[i] = vn[i];
    }
}
__device__ __forceinline__ void p1_norm1(const Ptrs& p, int G) {
    const int tid = tid_fresh(), lane = tid & 63, w = tid >> 6;
    for (int row0 = (blockIdx.x * NWAVES + w) * 4; row0 < NROWS; row0 += G * NWAVES * 4) {
        f32x4 v[4][4];
#pragma unroll
        for (int q = 0; q < 4; ++q) { const int row = row0 + q; const float* src = (row < NCTX) ? p.ctx + (size_t)row * D : p.x + (size_t)(row - NCTX) * D;
#pragma unroll
            for (int j = 0; j < 4; ++j) v[q][j] = *(const f32x4*)(src + j * 256 + lane * 4); }
        const int mr = (row0 < NCTX) ? 16 : (row0 - NCTX) / T;
        const float* MOD = (const float*)(p.ws + WS_MOD) + (size_t)mr * NMOD;
        f32x4 sc[4], sh[4];
#pragma unroll
        for (int j = 0; j < 4; ++j) { const int c0 = j * 256 + lane * 4; sc[j] = *(const f32x4*)(p.norm_mix + c0) * (*(const f32x4*)(MOD + D + c0) + 1.f); sh[j] = *(const f32x4*)(MOD + c0); }
#pragma unroll
        for (int q = 0; q < 4; ++q) {
            float ss = 0.f;
#pragma unroll
            for (int j = 0; j < 4; ++j) ss += v[q][j][0] * v[q][j][0] + v[q][j][1] * v[q][j][1] + v[q][j][2] * v[q][j][2] + v[q][j][3] * v[q][j][3];
            const float rstd = rsqrtf(wave_sum(ss) * (1.f / D) + EPS);
            bf16_t* dst = (bf16_t*)(p.ws + WS_XN) + (size_t)(row0 + q) * D;
#pragma unroll
            for (int j = 0; j < 4; ++j) { const f32x4 o = v[q][j] * rstd * sc[j] + sh[j];
                pg8::u32x2 pk; pk.x = pg8::cvt_pk_bf16(o[0], o[1]); pk.y = pg8::cvt_pk_bf16(o[2], o[3]); *(pg8::u32x2*)(dst + j * 256 + lane * 4) = pk; }
        }
    }
}
__device__ __forceinline__ void p6_norm2_router(const Ptrs& p, LAS unsigned char* lds, int G) {
    const int tid = tid_fresh(), lane = tid & 63, w = __builtin_amdgcn_readfirstlane(tid >> 6), fr = lane & 15, fq = lane >> 4;
    LAS float* A2 = (LAS float*)lds;
    LAS float* B2 = (LAS float*)(lds + 4096);
    LAS float* LG = (LAS float*)(lds + 8192 + w * 8448);
    LAS bf16_t* WS = (LAS bf16_t*)(lds + 75776);
    LAS int* hist = (LAS int*)(lds + 131072);
    LAS float* brl = (LAS float*)(lds + 110592);
    const bf16_t* WR = (const bf16_t*)(p.ws + WS_WRT);
    for (int vw = blockIdx.x; vw < NTOK / 256; vw += G) {
        const float* MOD = (const float*)(p.ws + WS_MOD) + (size_t)(vw * 256 / T) * NMOD;
        __syncthreads();
        if (tid < 64) { hist[tid] = 0; brl[tid] = p.b_router[tid]; }
        for (int c = tid; c < D; c += NTHREADS) { A2[c] = p.norm_ffn[c] * (1.f + MOD[4 * D + c]); B2[c] = MOD[3 * D + c]; }
        const int tok0 = vw * 256 + w * 32;
        float rstd[2];
#pragma unroll
        for (int m = 0; m < 2; ++m) { const pg8::u32x2 q2 = *(const pg8::u32x2*)((const float*)(p.ws + WS_SSQ) + (size_t)(tok0 + 16 * m + fr) * 16 + 2 * fq); float sq = __uint_as_float(q2[0]) + __uint_as_float(q2[1]);
            sq += __shfl_xor(sq, 16); sq += __shfl_xor(sq, 32); rstd[m] = rsqrtf(sq * (1.f / D) + EPS); }
        f32x4 acc[2][4];
#pragma unroll
        for (int m = 0; m < 2; ++m)
#pragma unroll
            for (int n = 0; n < 4; ++n) acc[m][n] = (f32x4){0.f, 0.f, 0.f, 0.f};
        struct XS { u16x8 x[2]; };
        auto load_x = [&](XS& g, int s) {
            const int c0 = 32 * s + 8 * fq;
#pragma unroll
            for (int m = 0; m < 2; ++m) { const size_t off = (size_t)(tok0 + 16 * m + fr) * D + c0; g.x[m] = *(const u16x8*)((const bf16_t*)(p.ws + WS_X1B) + off); }
        };
        auto compute_step = [&](const XS& g, int s) {
            const int c0 = 32 * s + 8 * fq, kl = (s & 3) * 32 + 8 * fq;
            pg8::bf16x8 bh[4], bl[4];
#pragma unroll
            for (int n = 0; n < 4; ++n) { bh[n] = *(const LAS pg8::bf16x8*)(WS + (16 * n + fr) * 136 + kl); bl[n] = *(const LAS pg8::bf16x8*)(WS + 64 * 136 + (16 * n + fr) * 136 + kl); }
            const f32x4 a0 = *(const LAS f32x4*)(A2 + c0), a1 = *(const LAS f32x4*)(A2 + c0 + 4), b0 = *(const LAS f32x4*)(B2 + c0), b1 = *(const LAS f32x4*)(B2 + c0 + 4);
#pragma unroll
            for (int m = 0; m < 2; ++m) {
                const size_t off = (size_t)(tok0 + 16 * m + fr) * D + c0;
                const f32x4 xa0 = {bf2f(g.x[m][0]), bf2f(g.x[m][1]), bf2f(g.x[m][2]), bf2f(g.x[m][3])}, xa1 = {bf2f(g.x[m][4]), bf2f(g.x[m][5]), bf2f(g.x[m][6]), bf2f(g.x[m][7])};
                const f32x4 h0 = xa0 * rstd[m] * a0 + b0, h1 = xa1 * rstd[m] * a1 + b1;
                pg8::u32x4 hi; hi.x = pg8::cvt_pk_bf16(h0[0], h0[1]); hi.y = pg8::cvt_pk_bf16(h0[2], h0[3]); hi.z = pg8::cvt_pk_bf16(h1[0], h1[1]); hi.w = pg8::cvt_pk_bf16(h1[2], h1[3]);
                *(pg8::u32x4*)((bf16_t*)(p.ws + WS_H2) + off) = hi;
                f32x4 r0, r1;
                r0[0] = h0[0] - __builtin_bit_cast(float, hi.x << 16); r0[1] = h0[1] - __builtin_bit_cast(float, hi.x & 0xffff0000u); r0[2] = h0[2] - __builtin_bit_cast(float, hi.y << 16); r0[3] = h0[3] - __builtin_bit_cast(float, hi.y & 0xffff0000u);
                r1[0] = h1[0] - __builtin_bit_cast(float, hi.z << 16); r1[1] = h1[1] - __builtin_bit_cast(float, hi.z & 0xffff0000u); r1[2] = h1[2] - __builtin_bit_cast(float, hi.w << 16); r1[3] = h1[3] - __builtin_bit_cast(float, hi.w & 0xffff0000u);
                pg8::u32x4 lo; lo.x = pg8::cvt_pk_bf16(r0[0], r0[1]); lo.y = pg8::cvt_pk_bf16(r0[2], r0[3]); lo.z = pg8::cvt_pk_bf16(r1[0], r1[1]); lo.w = pg8::cvt_pk_bf16(r1[2], r1[3]);
                const pg8::bf16x8 ah = __builtin_bit_cast(pg8::bf16x8, hi), al = __builtin_bit_cast(pg8::bf16x8, lo);
#pragma unroll
                for (int n = 0; n < 4; ++n) {
                    acc[m][n] = __builtin_amdgcn_mfma_f32_16x16x32_bf16(ah, bh[n], acc[m][n], 0, 0, 0);
                    acc[m][n] = __builtin_amdgcn_mfma_f32_16x16x32_bf16(ah, bl[n], acc[m][n], 0, 0, 0);
                    acc[m][n] = __builtin_amdgcn_mfma_f32_16x16x32_bf16(al, bh[n], acc[m][n], 0, 0, 0);
                }
            }
        };
        XS x0, x1, x2, x3;
        load_x(x0, 0); load_x(x1, 1); load_x(x2, 2); load_x(x3, 3);
        for (int q = 0; q < 8; ++q) {
            u16x8 wv[4];
#pragma unroll
            for (int i = 0; i < 4; ++i) { const int idx = tid + NTHREADS * i, hl = idx >> 10, e = (idx >> 4) & 63, c = idx & 15; wv[i] = *(const u16x8*)(WR + (size_t)hl * NE * D + (size_t)e * D + q * 128 + c * 8); }
            __syncthreads();
#pragma unroll
            for (int i = 0; i < 4; ++i) { const int idx = tid + NTHREADS * i, hl = idx >> 10, e = (idx >> 4) & 63, c = idx & 15; *(LAS u16x8*)(WS + hl * 64 * 136 + e * 136 + c * 8) = wv[i]; }
            __syncthreads();
            const int s = 4 * q;
            compute_step(x0, s);     if (s + 4 < 32) load_x(x0, s + 4);
            compute_step(x1, s + 1); if (s + 5 < 32) load_x(x1, s + 5);
            compute_step(x2, s + 2); if (s + 6 < 32) load_x(x2, s + 6);
            compute_step(x3, s + 3); if (s + 7 < 32) load_x(x3, s + 7);
        }
#pragma unroll
        for (int m = 0; m < 2; ++m)
#pragma unroll
            for (int n = 0; n < 4; ++n)
#pragma unroll
                for (int j = 0; j < 4; ++j) LG[(16 * m + 4 * fq + j) * 65 + 16 * n + fr] = acc[m][n][j];
        asm volatile("s_waitcnt lgkmcnt(0)" ::: "memory");
        if (lane < 32) {
            const int tok = tok0 + lane;
            float sv[64];
            float gs[8];
#pragma unroll
            for (int g = 0; g < 8; ++g) {
                float m1 = -INFINITY, m2 = -INFINITY;
#pragma unroll
                for (int i = 0; i < 8; ++i) { const int e = 8 * g + i; const float sg = __builtin_amdgcn_rcpf(1.f + __builtin_amdgcn_exp2f(-1.4426950408889634f * LG[lane * 65 + e])); sv[e] = sg;
                    const float sb = sg + brl[e]; if (sb > m1) { m2 = m1; m1 = sb; } else if (sb > m2) m2 = sb; }
                gs[g] = m1 + m2;
            }
            unsigned gsel = 0;
#pragma unroll
            for (int g = 0; g < 8; ++g) { int rk = 0;
#pragma unroll
                for (int g2 = 0; g2 < 8; ++g2) rk += (gs[g2] > gs[g] || (gs[g2] == gs[g] && g2 < g)) ? 1 : 0;
                if (rk < 4) gsel |= 1u << g; }
            float tv[TOPK]; int ti[TOPK];
#pragma unroll
            for (int k = 0; k < TOPK; ++k) { tv[k] = -INFINITY; ti[k] = 0; }
#pragma unroll
            for (int e = 0; e < 64; ++e) {
                float cx = ((gsel >> (e >> 3)) & 1u) ? sv[e] + brl[e] : -INFINITY; int ci = e;
#pragma unroll
                for (int k = 0; k < TOPK; ++k) { const bool gt = cx > tv[k]; const float ov = tv[k]; const int oi = ti[k]; tv[k] = gt ? cx : ov; ti[k] = gt ? ci : oi; cx = gt ? ov : cx; ci = gt ? oi : ci; }
            }
            float ssum = 0.f, sk[TOPK];
#pragma unroll
            for (int k = 0; k < TOPK; ++k) { sk[k] = tv[k] - brl[ti[k]]; ssum += sk[k]; }
            const float inv = 2.5f / ssum;
#pragma unroll
            for (int k = 0; k < TOPK; ++k) { const int pos = __hip_atomic_fetch_add(&hist[ti[k]], 1, __ATOMIC_RELAXED, __HIP_MEMORY_SCOPE_WORKGROUP);
                ((int*)(p.ws + WS_EIDX))[(size_t)tok * TOPK + k] = ti[k] | (pos << 8); ((float*)(p.ws + WS_GATE))[(size_t)tok * TOPK + k] = sk[k] * inv; }
        }
        __syncthreads();
        if (tid < 64) ((int*)(p.ws + WS_HIST))[vw * 64 + tid] = hist[tid];
    }
}

__global__ void __launch_bounds__(NTHREADS, 2) mega(Args args) {
    extern __shared__ __attribute__((aligned(16))) unsigned char lds_raw[];
    LAS unsigned char* lds = (LAS unsigned char*)lds_raw;
    const Ptrs& p = args.p;
    const int tid = tid_fresh(), G = gridDim.x;
    volatile LAS unsigned* MISC = (volatile LAS unsigned*)(lds + MISC_OFF);
    for (int u = tid; u < (LDS_BYTES - RING_BYTES) / 4; u += NTHREADS) ((LAS unsigned*)(lds + RING_BYTES))[u] = 0u;
    __syncthreads();
    unsigned* ctl = (unsigned*)(p.ws + WS_CTL);
    XcdBarrier bar = xcd_barrier_post(ctl + CW_BAR, MISC + 8);
    const int lo = args.ph_lo, hi = args.ph_hi;
#define IN(k) (lo <= (k) && (k) < hi)
#define SEAM(k) do { if (IN(k) && IN((k) + 1)) xcd_barrier(bar); } while (0)
    if (IN(0)) p0_prologue(p, lds, G);
    SEAM(0);
    if (IN(1)) p1_norm1(p, G);
    SEAM(1);
    if (IN(2)) {
        pg8::DenseOrder S; S.init(p.ws + WS_XN, p.ws + WS_WINT, NROWS, NPROJ, D, G, (int)blockIdx.x);
        EpiInProj E{(bf16_t*)(p.ws + WS_PROJ), (const float*)(p.ws + WS_ROPE)};
        pg8::gemm_phase<EpiInProj, pg8::DenseOrder, false>(lds, D, S, E, nullptr);
    }
    SEAM(2);
    const int upair = ((G & 15) == 0) ? (((int)blockIdx.x >> 4) * 16 + ((int)blockIdx.x & 7) * 2 + (((int)blockIdx.x >> 3) & 1)) : (int)blockIdx.x;
    if (IN(3)) { for (int u = upair; u < NB * NBLK * 2; u += G) lru_unit(p, lds, u); }
    if (IN(3)) { for (int u = upair; u < NB * NH * 4; u += G) ret_state_walk(p, lds, u); }
    SEAM(3);
    if (IN(4)) { for (int u = blockIdx.x; u < NB * NH * 32; u += G) ret_chunk_out(p, lds, u, (u + G < NB * NH * 32) ? u + G : -1, u == (int)blockIdx.x); }
    SEAM(4);
    if (IN(5)) {
        pg8::DenseOrder S; S.init(p.ws + WS_Y, p.ws + WS_WOUTT, NTOK, D, D, G, (int)blockIdx.x);
        EpiOutProj E{p.x, (const float*)(p.ws + WS_MOD), (bf16_t*)(p.ws + WS_X1B), (float*)(p.ws + WS_SSQ)};
        pg8::gemm_phase<EpiOutProj, pg8::DenseOrder, false>(lds, D, S, E, nullptr);
    }
    SEAM(5);
    if (IN(6)) p6_norm2_router(p, lds, G);
    SEAM(6);
    if (IN(7)) {
        const int tid = tid_fresh();
        LAS int* sm = (LAS int*)lds;
        const int* HIST = (const int*)(p.ws + WS_HIST); const int* EI = (const int*)(p.ws + WS_EIDX);
        int* TOKL = (int*)(p.ws + WS_LIST); int* SLOT = (int*)(p.ws + WS_LIST) + LIST_N;
        int* TILE = (int*)(p.ws + WS_TILE);
        for (int vw = blockIdx.x; vw < NTOK / 256; vw += G) {
            const int q = vw / GPP, wl = vw % GPP, e = tid & 63, g = tid >> 6;
            int tot = 0, bef = 0;
            for (int w = (GPP / 8) * g; w < (GPP / 8) * (g + 1); ++w) { const int v = HIST[(q * GPP + w) * 64 + e]; tot += v; if (w < wl) bef += v; }
            sm[g * 64 + e] = tot; sm[512 + g * 64 + e] = bef;
            __syncthreads();
            if (tid < 64) {
                int total = 0, before = 0;
#pragma unroll
                for (int gg = 0; gg < 8; ++gg) { total += sm[gg * 64 + tid]; before += sm[512 + gg * 64 + tid]; }
                const int padded = (total + 255) & ~255; int incl = padded;
#pragma unroll
                for (int o = 1; o < 64; o <<= 1) { const int t = __shfl_up(incl, o); if (tid >= o) incl += t; }
                const int pstart = incl - padded;
                sm[1024 + tid] = total; sm[1088 + tid] = pstart; sm[1152 + tid] = pstart + before; if (tid == 63) sm[1216] = incl >> 8;
            }
            __syncthreads();
            const size_t lb = (size_t)q * SLOTS_PART;
            for (int a = tid; a < 256 * TOPK; a += NTHREADS) {
                const int tl = a / TOPK, k = a - tl * TOPK, tok = vw * 256 + tl, pk = EI[(size_t)tok * TOPK + k], ee = pk & 255, pos = pk >> 8;
                const size_t slot = lb + sm[1152 + ee] + pos;
                TOKL[slot] = tok; SLOT[(size_t)tok * TOPK + k] = (int)slot;
            }
            if (tid < 256) { const size_t slot = lb + (size_t)RT_ROUTED * 256 + wl * 256 + tid; TOKL[slot] = vw * 256 + tid; }
            if (wl < 64) { const int cnt = sm[1024 + wl], st = sm[1088 + wl], pe = (cnt + 255) & ~255;
                for (int i = cnt + tid; i < pe; i += NTHREADS) { const size_t slot = lb + st + i; TOKL[slot] = q * PTOK; } }
            if (wl == 64) { const int nrt = sm[1216];
                for (int rt = tid; rt < nrt; rt += NTHREADS) { int ee = 0; for (int x = 1; x < 64; ++x) if (sm[1088 + x] <= rt * 256) ee = x; TILE[64 + q * RT_PART + rt] = ee; }
                if (tid == 0) TILE[q] = nrt; }
            __syncthreads();
        }
    }
    SEAM(7);
#ifndef NO_P8
    if (IN(8)) {
        const int* TILE = (const int*)(p.ws + WS_TILE);
        MoeOrderGU S0{(const char*)(p.ws + WS_H2), (const char*)(p.ws + WS_WGUT), TILE + 64, TILE[0], (NPART > 1) ? TILE[1] : 0, G, (int)blockIdx.x};
        LAS int* DSC = (LAS int*)(lds + RING_BYTES); LAS int* RLC = DSC + MOE_DSC_N;
        { const int tq = tid_fresh(); const int* TOKL = (const int*)(p.ws + WS_LIST);
          __syncthreads();
          if (tq < MOE_DSC_N) { pg8::Unit u; const bool ok = S0.next(tq, u); DSC[tq] = ok ? (u.pm | (u.pn << 16) | (u.aux << 20)) : -1; }
          __syncthreads();
#pragma unroll
          for (int k = 0; k < MOE_RL_UNITS * 256 / NTHREADS; ++k) { const int idx = tq + NTHREADS * k, i = idx >> 8, d = DSC[i]; if (d >= 0) RLC[idx] = TOKL[(size_t)(d & 0xffff) * 256 + (idx & 255)]; }
          __syncthreads(); }
        LdsOrderGU S{(const char*)(p.ws + WS_H2), (const char*)(p.ws + WS_WGUT), DSC};
        EpiGateUp E{(bf16_t*)(p.ws + WS_HB)};
        pg8::gemm_phase<EpiGateUp, LdsOrderGU, true>(lds, D, S, E, RLC);
    }
#endif
    SEAM(8);
    if (IN(9)) {
        const int* TILE = (const int*)(p.ws + WS_TILE);
        MoeOrderDown S0{(const char*)(p.ws + WS_HB), (const char*)(p.ws + WS_WDT), TILE + 64, TILE[0], (NPART > 1) ? TILE[1] : 0, G, (int)blockIdx.x};
        LAS int* DSC = (LAS int*)(lds + RING_BYTES);
        { const int tq = tid_fresh();
          __syncthreads();
          if (tq < MOE_DSC_N) { pg8::Unit u; const bool ok = S0.next(tq, u); DSC[tq] = ok ? (u.pm | (u.pn << 16) | (u.aux << 20)) : -1; }
          __syncthreads(); }
        LdsOrderDown S{(const char*)(p.ws + WS_HB), (const char*)(p.ws + WS_WDT), DSC};
        EpiDown E{(unsigned char*)(p.ws + WS_YT)};
        int Kd = DE; asm volatile("" : "+s"(Kd));
        pg8::gemm_phase<EpiDown, LdsOrderDown, false>(lds, Kd, S, E, nullptr);
    }
    SEAM(9);
    if (IN(10)) {
        const int tid10 = tid_fresh(), lane = tid10 & 63, wv = tid10 >> 6;
        const unsigned char* YT = (const unsigned char*)(p.ws + WS_YT);
        typedef float f32x2 __attribute__((ext_vector_type(2)));
        for (int tok0 = (blockIdx.x * NWAVES + wv) * 2; tok0 < NTOK; tok0 += G * NWAVES * 2) {
            const float* MODb = (const float*)(p.ws + WS_MOD) + (size_t)(tok0 / T) * NMOD + 5 * D + lane * 4;
            pg8::u32x4 yv[2][7]; pg8::u32x2 xq[2][4]; float gk[2][7];
            const int* SLOT = (const int*)(p.ws + WS_LIST) + LIST_N; const float* GT = (const float*)(p.ws + WS_GATE);
#pragma unroll
            for (int q = 0; q < 2; ++q) {
                const int tok = tok0 + q, part = tok / PTOK;
#pragma unroll
                for (int k = 0; k < 7; ++k) { const size_t slot = (k < TOPK) ? (size_t)SLOT[(size_t)tok * TOPK + k] : (size_t)part * SLOTS_PART + (size_t)RT_ROUTED * 256 + (tok - part * PTOK);
                    gk[q][k] = (k < TOPK) ? GT[(size_t)tok * TOPK + k] : 1.f;
                    yv[q][k] = *(const pg8::u32x4*)(YT + (((slot >> 8) * 4 + (size_t)(lane >> 4)) * 256 + (slot & 255)) * 256 + (lane & 15) * 16); }
                const bf16_t* x1r = (const bf16_t*)(p.ws + WS_X1B) + (size_t)tok * D + lane * 4;
#pragma unroll
                for (int i = 0; i < 4; ++i) xq[q][i] = *(const pg8::u32x2*)(x1r + 256 * i);
            }
            f32x4 g2[4], nf[4];
#pragma unroll
            for (int i = 0; i < 4; ++i) { g2[i] = *(const f32x4*)(MODb + 256 * i) * 0.0625f; nf[i] = *(const f32x4*)(p.norm_final + lane * 4 + 256 * i); }
#pragma unroll
            for (int q = 0; q < 2; ++q) {
                float a[16];
#pragma unroll
                for (int j = 0; j < 16; ++j) a[j] = 0.f;
#pragma unroll
                for (int k = 0; k < 7; ++k)
#pragma unroll
                    for (int i = 0; i < 4; ++i) { const int wd = (int)yv[q][k][i]; const f32x2 lo = __builtin_amdgcn_cvt_pk_f32_fp8(wd, false), hi = __builtin_amdgcn_cvt_pk_f32_fp8(wd, true);
                        a[4 * i] += gk[q][k] * lo[0]; a[4 * i + 1] += gk[q][k] * lo[1]; a[4 * i + 2] += gk[q][k] * hi[0]; a[4 * i + 3] += gk[q][k] * hi[1]; }
                f32x4 v[4]; float ss = 0.f;
#pragma unroll
                for (int i = 0; i < 4; ++i) { const f32x4 av = {a[4 * i], a[4 * i + 1], a[4 * i + 2], a[4 * i + 3]};
                    const unsigned w0 = xq[q][i][0], w1 = xq[q][i][1];
                    const f32x4 xv = {__uint_as_float(w0 << 16), __uint_as_float(w0 & 0xffff0000u), __uint_as_float(w1 << 16), __uint_as_float(w1 & 0xffff0000u)};
                    v[i] = xv + g2[i] * av; ss += v[i][0] * v[i][0] + v[i][1] * v[i][1] + v[i][2] * v[i][2] + v[i][3] * v[i][3]; }
                const float rstd = rsqrtf(wave_sum(ss) * (1.f / D) + EPS);
                float* xr = p.out + (size_t)(tok0 + q) * D + lane * 4;
#pragma unroll
                for (int i = 0; i < 4; ++i) *(f32x4*)(xr + 256 * i) = v[i] * rstd * nf[i];
            }
        }
    }
    SEAM(10);
#undef IN
#undef SEAM
}

static void launch_mega(const Ptrs& p, int lo, int hi, hipStream_t stream) {
    static int grid = 0;
    if (grid == 0) {
        int dev = 0, cus = 0, per_cu = 0;
        (void)hipGetDevice(&dev); (void)hipDeviceGetAttribute(&cus, hipDeviceAttributeMultiprocessorCount, dev);
        if (hipFuncSetAttribute((const void*)mega, hipFuncAttributeMaxDynamicSharedMemorySize, LDS_BYTES) != hipSuccess) { fprintf(stderr, "hipFuncSetAttribute failed\n"); grid = -1; return; }
        if (hipOccupancyMaxActiveBlocksPerMultiprocessor(&per_cu, (const void*)mega, NTHREADS, LDS_BYTES) != hipSuccess || per_cu < 1) fprintf(stderr, "occupancy query reports %d blocks per CU\n", per_cu);
        (void)hipGetLastError();
        grid = cus > 0 ? cus : 256;
    }
    if (grid < 0) return;
    Args a{}; a.p = p; a.ph_lo = lo; a.ph_hi = hi;
    hipLaunchKernelGGL(mega, dim3(grid), dim3(NTHREADS), LDS_BYTES, stream, a);
}

extern "C" void kernel_launch(void* const* d_in, const int* in_sizes, int n_in, void* d_out, int out_size, void* d_ws, size_t ws_size, hipStream_t stream) {
    if (n_in != 26 || out_size != NTOK * D || ws_size < WS_END) { fprintf(stderr, "kernel_launch: unexpected problem (n_in %d out %d ws %zu)\n", n_in, out_size, ws_size); return; }
    Ptrs p{};
    const float** f = (const float**)&p;
    for (int i = 0; i < 26; ++i) f[i] = (const float*)d_in[i];
    p.out = (float*)d_out; p.ws = (unsigned char*)d_ws;
    (void)hipMemsetAsync(p.ws + WS_CTL, 0, CTL_ZERO_BYTES, stream);
    launch_mega(p, 0, 11, stream);
}
```
